# Optimizing an MI355X kernel written in HIP

```python
import jax, jax.numpy as jnp
from jax import lax
import numpy as np

D_MODEL = 1024
BATCH = 16
SEQ = 4096
DEPTH = 4

MEM_LEN = 256
CONV_WIDTH = 512
CONV_K = 3
HG_HEADS = 4
HG_F = 128
HG_I = 128
HG_QK = HG_HEADS * HG_F
HG_WIDTH = HG_HEADS * HG_I
HG_CHUNK = 32
MEM_HEADS = 4
MEM_HEAD_DIM = 128
MEM_WIDTH = MEM_HEADS * MEM_HEAD_DIM
N_BRANCH = 3
BRANCH_WIDTH = 512
D_FF = 4 * D_MODEL
ALPHA = (2.0 * DEPTH) ** 0.25
BETA = (8.0 * DEPTH) ** -0.25
LN_EPS = 1e-5
RMS_EPS = 1e-6
IN_SPLITS = (CONV_WIDTH, CONV_WIDTH, CONV_WIDTH, HG_QK, HG_QK, HG_WIDTH, HG_WIDTH, MEM_WIDTH, D_MODEL, D_MODEL, D_MODEL)
IN_COLS = sum(IN_SPLITS)

kernel_name = "hybrid_conv_hgrn2_memattn_postnorm"


def _layer_norm(x, g, b):
    xf = x.astype(jnp.float32)
    mu = jnp.mean(xf, axis=-1, keepdims=True)
    var = jnp.mean(jnp.square(xf - mu), axis=-1, keepdims=True)
    y = (xf - mu) * lax.rsqrt(var + LN_EPS) * g.astype(jnp.float32) + b.astype(jnp.float32)
    return y.astype(x.dtype)


def _short_conv_mixer(gate_b, gate_c, h, conv_w):
    u = gate_c * h
    seq = u.shape[1]
    u_pad = jnp.pad(u, ((0, 0), (CONV_K - 1, 0), (0, 0)))
    y = u_pad[:, 0:seq] * conv_w[0]
    for tap in range(1, CONV_K):
        y = y + u_pad[:, tap:tap + seq] * conv_w[tap]
    return gate_b * y


def _hgrn2_mixer(q, f_logit, i, g, lb, norm_w):
    bsz, seq, _ = q.shape
    n_chunk = seq // HG_CHUNK
    f32 = jnp.float32
    fl = f_logit.astype(f32)
    lb = lb.astype(f32)
    sig = jax.nn.sigmoid(fl)
    log_f = jnp.log(lb + (1.0 - lb) * sig)
    k = (1.0 - lb) * jax.nn.sigmoid(-fl)

    def to_chunks(t, d):
        return t.reshape(bsz, n_chunk, HG_CHUNK, HG_HEADS, d).transpose(0, 3, 1, 2, 4)

    qc = to_chunks(jax.nn.silu(q.astype(f32)), HG_F)
    kc = to_chunks(k, HG_F)
    vc = to_chunks(i.astype(f32), HG_I)
    bc = jnp.cumsum(to_chunks(log_f, HG_F), axis=3)
    b_ref = bc[:, :, :, HG_CHUNK // 2 - 1:HG_CHUNK // 2, :]
    b_last = bc[:, :, :, -1:, :]

    causal = jnp.tril(jnp.ones((HG_CHUNK, HG_CHUNK), dtype=bool))
    scores = jnp.einsum('bhntf,bhnsf->bhnts', qc * jnp.exp(bc - b_ref), kc * jnp.exp(b_ref - bc))
    scores = jnp.where(causal, scores, 0.0)
    o_intra = jnp.einsum('bhnts,bhnsv->bhntv', scores, vc)

    q_in = qc * jnp.exp(bc)
    k_out = kc * jnp.exp(b_last - bc)
    decay = jnp.exp(b_last[:, :, :, 0, :])

    def step(state, xs):
        q_n, k_n, v_n, dec_n = xs
        o_n = jnp.einsum('bhtf,bhfv->bhtv', q_n, state)
        state = dec_n[..., None] * state + jnp.einsum('bhsf,bhsv->bhfv', k_n, v_n)
        return state, o_n

    xs = (jnp.moveaxis(q_in, 2, 0), jnp.moveaxis(k_out, 2, 0), jnp.moveaxis(vc, 2, 0), jnp.moveaxis(decay, 2, 0))
    init = jnp.zeros((bsz, HG_HEADS, HG_F, HG_I), f32)
    _, o_inter = lax.scan(step, init, xs)
    o = o_intra + jnp.moveaxis(o_inter, 0, 2)

    o = o.transpose(0, 2, 3, 1, 4).reshape(bsz, seq, HG_HEADS, HG_I)
    o = o * lax.rsqrt(jnp.mean(o * o, axis=-1, keepdims=True) + RMS_EPS) * norm_w.astype(f32)
    o = o.reshape(bsz, seq, HG_WIDTH) * jax.nn.silu(g.astype(f32))
    return o.astype(q.dtype)


def _memory_attention(q, mem_k, mem_v):
    bsz, seq, _ = q.shape
    qh = q.reshape(bsz, seq, MEM_HEADS, MEM_HEAD_DIM)
    kh = mem_k.reshape(bsz, MEM_LEN, MEM_HEADS, MEM_HEAD_DIM)
    vh = mem_v.reshape(bsz, MEM_LEN, MEM_HEADS, MEM_HEAD_DIM)
    s = jnp.einsum('bthd,bmhd->bhtm', qh, kh).astype(jnp.float32) * (MEM_HEAD_DIM ** -0.5)
    p = jax.nn.softmax(s, axis=-1).astype(vh.dtype)
    o = jnp.einsum('bhtm,bmhd->bthd', p, vh)
    return o.reshape(bsz, seq, MEM_WIDTH)


def _hybrid_layer(x, mem, lb, w_in, conv_w, hg_norm_w, w_mem_k, w_mem_v, w_branch, b_gate, w_o,
                  ln1_g, ln1_b, w_up, w_down, ln2_g, ln2_b):
    bsz, seq, _ = x.shape
    proj = jnp.einsum('bsd,dc->bsc', x, w_in)
    split_idx = [int(v) for v in np.cumsum(IN_SPLITS)[:-1]]
    cb, cc, ch, hq, hf, hi, hg, mq, ga, gb, gc = jnp.split(proj, split_idx, axis=-1)

    y_a = _short_conv_mixer(cb, cc, ch, conv_w)
    y_b = _hgrn2_mixer(hq, hf, hi, hg, lb, hg_norm_w)
    y_c = _memory_attention(mq, jnp.einsum('bmd,dw->bmw', mem, w_mem_k), jnp.einsum('bmd,dw->bmw', mem, w_mem_v))

    b_ga, b_gb, b_gc = jnp.split(b_gate, N_BRANCH, axis=-1)
    merged = (jax.nn.sigmoid(ga + b_ga) * jnp.einsum('bsw,wd->bsd', y_a, w_branch[0])
              + jax.nn.sigmoid(gb + b_gb) * jnp.einsum('bsw,wd->bsd', y_b, w_branch[1])
              + jax.nn.sigmoid(gc + b_gc) * jnp.einsum('bsw,wd->bsd', y_c, w_branch[2]))
    mixed = jnp.einsum('bsd,de->bse', merged, w_o)
    x = _layer_norm(ALPHA * x + mixed, ln1_g, ln1_b)

    h = jnp.square(jax.nn.relu(jnp.einsum('bsd,df->bsf', x, w_up)))
    x = _layer_norm(ALPHA * x + jnp.einsum('bsf,fd->bsd', h, w_down), ln2_g, ln2_b)
    return x


def setup_inputs(seed: int = 0) -> dict:
    key = jax.random.key(seed)
    ks = jax.random.split(key, 20)
    nrm = jax.random.normal
    f32 = jnp.float32
    return {
        'x': nrm(ks[0], (BATCH, SEQ, D_MODEL), f32),
        'mem': nrm(ks[1], (BATCH, MEM_LEN, D_MODEL), f32),
        'lower_bounds': 0.02 * nrm(ks[2], (DEPTH, HG_QK), f32),
        'w_in': nrm(ks[3], (DEPTH, D_MODEL, IN_COLS), f32) * D_MODEL ** -0.5,
        'conv_w': nrm(ks[4], (DEPTH, CONV_K, CONV_WIDTH), f32) * CONV_K ** -0.5,
        'hg_norm_w': 1.0 + 0.02 * nrm(ks[5], (DEPTH, HG_I), f32),
        'w_mem_k': nrm(ks[6], (DEPTH, D_MODEL, MEM_WIDTH), f32) * D_MODEL ** -0.5,
        'w_mem_v': nrm(ks[7], (DEPTH, D_MODEL, MEM_WIDTH), f32) * (D_MODEL ** -0.5 * BETA),
        'w_branch': nrm(ks[8], (DEPTH, N_BRANCH, BRANCH_WIDTH, D_MODEL), f32) * (BRANCH_WIDTH ** -0.5 * BETA),
        'b_gate': 0.02 * nrm(ks[9], (DEPTH, N_BRANCH * D_MODEL), f32),
        'w_o': nrm(ks[10], (DEPTH, D_MODEL, D_MODEL), f32) * (D_MODEL ** -0.5 * BETA),
        'ln1_g': 1.0 + 0.02 * nrm(ks[11], (DEPTH, D_MODEL), f32),
        'ln1_b': 0.02 * nrm(ks[12], (DEPTH, D_MODEL), f32),
        'w_up': nrm(ks[13], (DEPTH, D_MODEL, D_FF), f32) * (D_MODEL ** -0.5 * BETA),
        'w_down': nrm(ks[14], (DEPTH, D_FF, D_MODEL), f32) * (D_FF ** -0.5 * BETA),
        'ln2_g': 1.0 + 0.02 * nrm(ks[15], (DEPTH, D_MODEL), f32),
        'ln2_b': 0.02 * nrm(ks[16], (DEPTH, D_MODEL), f32),
    }


def reference(x, mem, lower_bounds, w_in, conv_w, hg_norm_w, w_mem_k, w_mem_v, w_branch, b_gate, w_o,
              ln1_g, ln1_b, w_up, w_down, ln2_g, ln2_b):
    lb_soft = jax.nn.softmax(lower_bounds.astype(jnp.float32), axis=0)
    lb_all = jnp.cumsum(lb_soft, axis=0) - lb_soft[0:1]
    for layer in range(DEPTH):
        x = _hybrid_layer(x, mem, lb_all[layer], w_in[layer], conv_w[layer], hg_norm_w[layer],
                          w_mem_k[layer], w_mem_v[layer], w_branch[layer], b_gate[layer], w_o[layer],
                          ln1_g[layer], ln1_b[layer], w_up[layer], w_down[layer], ln2_g[layer], ln2_b[layer])
    return x
```

```cpp
#include <hip/hip_runtime.h>
#include <hip/hip_cooperative_groups.h>
#include <cstdio>
#include <cstdint>
namespace cg = cooperative_groups;

#define LAS __attribute__((address_space(3)))
typedef unsigned short bf16_t;
typedef short bf16x8 __attribute__((ext_vector_type(8)));
typedef short s16x4 __attribute__((ext_vector_type(4)));
typedef float f32x4 __attribute__((ext_vector_type(4)));
typedef unsigned u32x4 __attribute__((ext_vector_type(4)));
typedef unsigned u32x2 __attribute__((ext_vector_type(2)));

constexpr int M = 65536, D = 1024, INC = 7168, FF = 4096, SEQ = 4096, NBATCH = 16, MEML = 256, DEPTH = 4;
constexpr int RC = 32768, NCH = M / RC, BPC = RC / SEQ;
constexpr int YW = 1536;
constexpr int C_CB = 0, C_CC = 512, C_CH = 1024, C_HQ = 1536, C_HF = 2048, C_HI = 2560, C_HG = 3072, C_MQ = 3584, C_G = 4096;
constexpr float ALPHA = 1.6817928305074292f, LN_EPS = 1e-5f, RMS_EPS = 1e-6f;
constexpr int HSEG = 256, NSEG = SEQ / HSEG;

constexpr size_t MiB = 1u << 20;
constexpr size_t WS_WIN = 0, WS_WKV = 56 * MiB, WS_WB = 64 * MiB, WS_WO = 76 * MiB, WS_WUP = 84 * MiB, WS_WDN = 116 * MiB;
constexpr size_t WS_XN = 148 * MiB, WS_MEMB = 276 * MiB, WS_MKV = 284 * MiB, WS_Y = 316 * MiB, WS_MG = 412 * MiB;
constexpr size_t WS_SLOC = 476 * MiB, WS_DLOC = 508 * MiB, WS_PROJ = 512 * MiB, WS_H = WS_PROJ, WS_END = 960 * MiB;
static_assert(WS_PROJ + (size_t)RC * INC * 2 <= WS_END && WS_H + (size_t)RC * FF * 2 <= WS_END, "ws map");
static_assert((size_t)BPC * 4 * NSEG * 128 * 128 * 4 <= WS_DLOC - WS_SLOC, "ws map");

constexpr int LDS_BYTES = 147456;

typedef float f32x2_t __attribute__((ext_vector_type(2))); typedef __bf16 bf16x2_t __attribute__((ext_vector_type(2)));
__device__ __forceinline__ unsigned cvt_pk_bf16_c(float lo, float hi) { f32x2_t v = {lo, hi}; bf16x2_t b = __builtin_convertvector(v, bf16x2_t); return __builtin_bit_cast(unsigned, b); }
__device__ __forceinline__ unsigned cvt_pk_bf16(float lo, float hi) { unsigned r; asm volatile("v_cvt_pk_bf16_f32 %0, %1, %2" : "=v"(r) : "v"(lo), "v"(hi)); return r; }
__device__ __forceinline__ unsigned short f2bf(float f) { return (unsigned short)(cvt_pk_bf16_c(f, 0.f) & 0xffffu); }
__device__ __forceinline__ float bf2f(unsigned short b) { return __uint_as_float((unsigned)b << 16); }
__device__ __forceinline__ float bflo(unsigned w) { return __uint_as_float(w << 16); }
__device__ __forceinline__ float bfhi(unsigned w) { return __uint_as_float(w & 0xffff0000u); }
__device__ __forceinline__ float sigmoidf_(float x) { return 1.0f / (1.0f + __expf(-x)); }
__device__ __forceinline__ float wave_sum(float v) {
#pragma unroll
    for (int o = 1; o < 64; o <<= 1) v += __shfl_xor(v, o);
    return v;
}
#define LDS_WAIT() asm volatile("s_waitcnt lgkmcnt(0)" ::: "memory")
__device__ __forceinline__ int opaque_tid() { int t = threadIdx.x; asm volatile("" : "+v"(t)); return t; }

namespace pg8 {
constexpr int BM = 256, BK = 64, HALF = 128, HTB = HALF * BK * 2, STAGE_BYTES = 8 * HTB, NXCD = 8, WGM = 8;
__device__ __forceinline__ int lds_byte(int r, int c) { const int st = (r >> 4) * 2 + (c >> 5), rr = r & 15, cc = c & 31, ob = rr * 64 + cc * 2; return st * 1024 + (ob ^ (((ob >> 9) & 1) << 5)); }
__device__ __forceinline__ void stage_rc(int b, int& R, int& C) { const int st = b / 1024, sb = b % 1024, swz = sb ^ (((sb >> 9) & 1) << 5); R = (st >> 1) * 16 + swz / 64; C = (st & 1) * 32 + (swz % 64) / 2; }
__device__ __forceinline__ int perm32(int rho) { const int n = rho >> 4, i = rho & 15; return 8 * (i >> 2) + 4 * n + (i & 3); }

struct Unit { int pm, pn, sub; };
struct Gemm { const bf16_t* A; const bf16_t* Bt; int lda, ldb, K; };

struct Order {
    int nM, nN, nwg, G, c, nsub;
    __device__ __forceinline__ void init(int nM_, int nN_, int G_, int c_, int nsub_) { nM = nM_; nN = nN_; nwg = nM * nN; G = G_; c = c_; nsub = nsub_; }
    __device__ __forceinline__ bool next(int i, Unit& u) const {
        const int ti = i / nsub; u.sub = i - ti * nsub;
        const long L = (long)ti * G + c; if (L >= nwg) return false;
        int wgid = (int)L; { const int q = nwg / NXCD, r = nwg % NXCD, xcd = wgid % NXCD, off = wgid / NXCD; wgid = (xcd < r ? xcd * (q + 1) : r * (q + 1) + (xcd - r) * q) + off; }
        const int nig = WGM * nN, gid = wgid / nig, fm = gid * WGM, gsz = (nM - fm) < WGM ? (nM - fm) : WGM;
        u.pm = fm + ((wgid % nig) % gsz); u.pn = (wgid % nig) / gsz; return true;
    }
};

template <int MODE> struct EpiStore {
    static constexpr bool PERM = true;
    bf16_t* O; int ldc; const float* bias;
    __device__ __forceinline__ bool keep(const Unit&) const { return false; }
    __device__ __forceinline__ void operator()(f32x4 (&acc)[2][2][4][2], const Unit& u, int wr, int wc, int fr, int fq) const {
        const int row0 = u.pm * BM + wr * 64 + fr; const int col0 = u.pn * BM + wc * 32 + 8 * fq;
        const bool gate = (MODE == 1) && (u.pn * BM >= C_G);
#pragma unroll
        for (int bj = 0; bj < 2; ++bj) {
            f32x4 b0 = (f32x4){0.f, 0.f, 0.f, 0.f}, b1 = b0;
            if (MODE == 1) { if (gate) { b0 = *(const f32x4*)(bias + col0 - C_G + bj * HALF); b1 = *(const f32x4*)(bias + col0 - C_G + bj * HALF + 4); } }
#pragma unroll
            for (int ai = 0; ai < 2; ++ai)
#pragma unroll
                for (int m = 0; m < 4; ++m) {
                    bf16_t* rowp = O + (size_t)(row0 + ai * HALF + m * 16) * ldc + col0 + bj * HALF;
                    f32x4 v0 = acc[ai][bj][m][0], v1 = acc[ai][bj][m][1];
                    if (MODE == 1) { if (gate) {
#pragma unroll
                        for (int j = 0; j < 4; ++j) { v0[j] = sigmoidf_(v0[j] + b0[j]); v1[j] = sigmoidf_(v1[j] + b1[j]); } } }
                    if (MODE == 2) {
#pragma unroll
                        for (int j = 0; j < 4; ++j) { const float a = fmaxf(v0[j], 0.f), b = fmaxf(v1[j], 0.f); v0[j] = a * a; v1[j] = b * b; } }
                    u32x4 w; w.x = cvt_pk_bf16(v0[0], v0[1]); w.y = cvt_pk_bf16(v0[2], v0[3]); w.z = cvt_pk_bf16(v1[0], v1[1]); w.w = cvt_pk_bf16(v1[2], v1[3]);
                    *(u32x4*)rowp = w;
                    asm volatile("" ::: "memory");
                }
        }
    }
};
struct EpiGate {
    static constexpr bool PERM = true;
    const bf16_t* P; bf16_t* O;
    __device__ __forceinline__ bool keep(const Unit& u) const { return u.sub < 2; }
    __device__ __forceinline__ void operator()(f32x4 (&acc)[2][2][4][2], const Unit& u, int wr, int wc, int fr, int fq) const {
        const int row0 = u.pm * BM + wr * 64 + fr; const int col0 = u.pn * BM + wc * 32 + 8 * fq;
        const bool last = (u.sub == 2);
#pragma unroll
        for (int ai = 0; ai < 2; ++ai)
#pragma unroll
            for (int m = 0; m < 4; ++m) {
                const size_t row = (size_t)(row0 + ai * HALF + m * 16);
#pragma unroll
                for (int bj = 0; bj < 2; ++bj) {
                    const bf16_t* gp = P + row * INC + C_G + u.sub * 1024 + col0 + bj * HALF;
                    const u32x4 ga = *(const u32x4*)gp;
                    float s[8] = {bflo(ga.x), bfhi(ga.x), bflo(ga.y), bfhi(ga.y), bflo(ga.z), bfhi(ga.z), bflo(ga.w), bfhi(ga.w)};
                    if (!last) {
                        const u32x4 gb = *(const u32x4*)(gp + 1024);
                        const float t[8] = {bflo(gb.x), bfhi(gb.x), bflo(gb.y), bfhi(gb.y), bflo(gb.z), bfhi(gb.z), bflo(gb.w), bfhi(gb.w)};
#pragma unroll
                        for (int j = 0; j < 8; ++j) s[j] = s[j] * __builtin_amdgcn_rcpf(fmaxf(t[j], 1e-30f));
                    }
                    f32x4 v0 = acc[ai][bj][m][0], v1 = acc[ai][bj][m][1];
#pragma unroll
                    for (int j = 0; j < 4; ++j) { v0[j] *= s[j]; v1[j] *= s[4 + j]; }
                    if (last) {
                        u32x4 w; w.x = cvt_pk_bf16(v0[0], v0[1]); w.y = cvt_pk_bf16(v0[2], v0[3]); w.z = cvt_pk_bf16(v1[0], v1[1]); w.w = cvt_pk_bf16(v1[2], v1[3]);
                        *(u32x4*)(O + row * D + col0 + bj * HALF) = w;
                    } else { acc[ai][bj][m][0] = v0; acc[ai][bj][m][1] = v1; }
                    asm volatile("" ::: "memory");
                }
            }
    }
};
struct EpiRes {
    static constexpr bool PERM = false;
    const float* base; float* out;
    __device__ __forceinline__ bool keep(const Unit&) const { return false; }
    __device__ __forceinline__ void operator()(f32x4 (&acc)[2][2][4][2], const Unit& u, int wr, int wc, int fr, int fq) const {
        const int row0 = u.pm * BM + wr * 64 + fr; const int col0 = u.pn * BM + wc * 32 + 4 * fq;
#pragma unroll
        for (int ai = 0; ai < 2; ++ai)
#pragma unroll
            for (int m = 0; m < 4; ++m) {
                const size_t off = (size_t)(row0 + ai * HALF + m * 16) * D + col0;
#pragma unroll
                for (int bj = 0; bj < 2; ++bj)
#pragma unroll
                    for (int n = 0; n < 2; ++n) { const f32x4 b = *(const f32x4*)(base + off + bj * HALF + n * 16); *(f32x4*)(out + off + bj * HALF + n * 16) = b * ALPHA + acc[ai][bj][m][n]; }
                asm volatile("" ::: "memory");
            }
    }
};

template <class Epi>
__device__ __forceinline__ void gemm_phase(LAS unsigned char* lds, const Gemm g, const Order& S, const Epi& E) {
    const int tid = opaque_tid(), wid = __builtin_amdgcn_readfirstlane(tid >> 6), lane = tid & 63, wr = wid >> 2, wc = wid & 3, fr = lane & 15, fq = lane >> 4;
    const int K = g.K, nt = K / BK;
    unsigned voffA[2], voffB[2];
#pragma unroll
    for (int i = 0; i < 2; ++i) { int R, C; stage_rc(tid * 16 + i * 8192, R, C); const int Rb = Epi::PERM ? ((R & ~31) + perm32(R & 31)) : R;
        voffA[i] = (unsigned)(R * g.lda + C) * 2u; voffB[i] = (unsigned)(Rb * g.ldb + C) * 2u; }
    const size_t kstep = (size_t)(BK * 2);
    const size_t hA = (size_t)HALF * g.lda * 2, hB = (size_t)HALF * g.ldb * 2, tA = 2 * hA, tB = 2 * hB;
    const unsigned ldsw = (unsigned)wid * 1024u;
    const int aoff = lds_byte(wr * 64 + fr, fq * 8), boff = lds_byte(wc * 32 + fr, fq * 8);
#define PG8_SA(b, h) (((b) * 2 + (h)) * HTB)
#define PG8_SB(b, h) ((4 + (b) * 2 + (h)) * HTB)
#define PG8_STAGE(bufoff, gbase, voff) do { _Pragma("unroll") for (int _i = 0; _i < 2; ++_i) \
        __builtin_amdgcn_global_load_lds((const unsigned*)((const char*)(gbase) + (voff)[_i]), (LAS unsigned*)(lds + (bufoff) + ldsw + _i * 8192), 16, 0, 0); } while (0)
#define PG8_LDA(dst, b, h) do { _Pragma("unroll") for (int m = 0; m < 4; ++m) _Pragma("unroll") for (int k = 0; k < 2; ++k) dst[m][k] = *(const LAS bf16x8*)(lds + PG8_SA(b, h) + aoff + m * 2048 + k * 1024); } while (0)
#define PG8_LDB(dst, b, h) do { _Pragma("unroll") for (int n = 0; n < 2; ++n) _Pragma("unroll") for (int k = 0; k < 2; ++k) dst[n][k] = *(const LAS bf16x8*)(lds + PG8_SB(b, h) + boff + n * 2048 + k * 1024); } while (0)
#define PG8_MMA(ai, bj, At, Bt) do { __builtin_amdgcn_s_setprio(1); _Pragma("unroll") for (int m = 0; m < 4; ++m) _Pragma("unroll") for (int n = 0; n < 2; ++n) _Pragma("unroll") for (int k = 0; k < 2; ++k) \
        acc[ai][bj][m][n] = __builtin_amdgcn_mfma_f32_16x16x32_bf16(Bt[n][k], At[m][k], acc[ai][bj][m][n], 0, 0, 0); __builtin_amdgcn_s_setprio(0); } while (0)
#define PG8_WAIT_V(n) asm volatile("s_waitcnt vmcnt(" #n ")" ::: "memory")
#define PG8_WAIT_L(n) asm volatile("s_waitcnt lgkmcnt(" #n ")" ::: "memory")
#define PG8_BAR __builtin_amdgcn_s_barrier()
#define PG8_SCHED __builtin_amdgcn_sched_barrier(0)
#define PG8_UA(u) ((const char*)g.A + (size_t)(u).pm * tA + (size_t)(u).sub * K * 2)
#define PG8_UB(u) ((const char*)g.Bt + (size_t)(u).pn * tB + (size_t)(u).sub * K * 2)
    Unit cur, nxt; int ui = 0;
    if (!S.next(0, cur)) return;
    f32x4 acc[2][2][4][2];
#pragma unroll
    for (int a = 0; a < 2; ++a)
#pragma unroll
        for (int b = 0; b < 2; ++b)
#pragma unroll
            for (int m = 0; m < 4; ++m)
#pragma unroll
                for (int n = 0; n < 2; ++n) acc[a][b][m][n] = (f32x4){0.f, 0.f, 0.f, 0.f};
    bf16x8 At[4][2], B0[2][2], B1[2][2];
    const char* cA = PG8_UA(cur); const char* cB = PG8_UB(cur);
    PG8_STAGE(PG8_SB(0, 0), cB, voffB); PG8_STAGE(PG8_SB(0, 1), cB + hB, voffB); PG8_STAGE(PG8_SA(0, 0), cA, voffA); PG8_STAGE(PG8_SA(0, 1), cA + hA, voffA);
    if (wr == 1) PG8_BAR;
    PG8_WAIT_V(2); PG8_BAR;
    PG8_STAGE(PG8_SB(1, 0), cB + kstep, voffB); PG8_STAGE(PG8_SA(1, 0), cA + kstep, voffA); PG8_STAGE(PG8_SB(1, 1), cB + hB + kstep, voffB);
    PG8_WAIT_V(6); PG8_BAR;
    for (;;) {
        const bool has_next = S.next(ui + 1, nxt);
        const char* nA = has_next ? PG8_UA(nxt) : cA; const char* nB = has_next ? PG8_UB(nxt) : cB;
        for (int t = 0; t < nt; t += 2) {
            const bool last = (t == nt - 2);
            const char* a1 = cA + (size_t)(t + 1) * kstep;
            const char* a2 = last ? nA : cA + (size_t)(t + 2) * kstep; const char* b2 = last ? nB : cB + (size_t)(t + 2) * kstep;
            const char* a3 = a2 + kstep; const char* b3 = b2 + kstep;
            PG8_LDB(B0, 0, 0); PG8_LDB(B1, 0, 1); PG8_SCHED; PG8_LDA(At, 0, 0); PG8_STAGE(PG8_SA(1, 1), a1 + hA, voffA);
            PG8_WAIT_V(8); PG8_WAIT_L(0); PG8_BAR; PG8_MMA(0, 0, At, B0); PG8_MMA(0, 1, At, B1); PG8_BAR; PG8_SCHED;
            PG8_LDA(At, 0, 1); PG8_STAGE(PG8_SB(0, 0), b2, voffB); PG8_STAGE(PG8_SB(0, 1), b2 + hB, voffB); PG8_STAGE(PG8_SA(0, 0), a2, voffA);
            PG8_WAIT_V(8); PG8_WAIT_L(0); PG8_BAR; PG8_MMA(1, 0, At, B0); PG8_MMA(1, 1, At, B1); PG8_BAR; PG8_SCHED;
            PG8_LDB(B0, 1, 0); PG8_LDB(B1, 1, 1); PG8_SCHED; PG8_LDA(At, 1, 0); PG8_STAGE(PG8_SA(0, 1), a2 + hA, voffA);
            PG8_WAIT_V(8); PG8_WAIT_L(0); PG8_BAR; PG8_MMA(0, 0, At, B0); PG8_MMA(0, 1, At, B1); PG8_BAR; PG8_SCHED;
            PG8_LDA(At, 1, 1); PG8_STAGE(PG8_SB(1, 0), b3, voffB); PG8_STAGE(PG8_SB(1, 1), b3 + hB, voffB); PG8_STAGE(PG8_SA(1, 0), a3, voffA);
            PG8_WAIT_V(8); PG8_WAIT_L(0); PG8_BAR; PG8_MMA(1, 0, At, B0); PG8_MMA(1, 1, At, B1); PG8_BAR; PG8_SCHED;
        }
        if (wr == 0) PG8_BAR;
        E(acc, cur, wr, wc, fr, fq);
        if (!has_next) break;
        if (!E.keep(cur)) {
#pragma unroll
            for (int a = 0; a < 2; ++a)
#pragma unroll
                for (int b = 0; b < 2; ++b)
#pragma unroll
                    for (int m = 0; m < 4; ++m)
#pragma unroll
                        for (int n = 0; n < 2; ++n) acc[a][b][m][n] = (f32x4){0.f, 0.f, 0.f, 0.f};
        }
        cur = nxt; cA = nA; cB = nB; ++ui;
        if (wr == 1) PG8_BAR;
    }
    PG8_WAIT_V(0);
    PG8_BAR;
#undef PG8_SA
#undef PG8_SB
#undef PG8_STAGE
#undef PG8_LDA
#undef PG8_LDB
#undef PG8_MMA
#undef PG8_WAIT_V
#undef PG8_WAIT_L
#undef PG8_BAR
#undef PG8_SCHED
#undef PG8_UA
#undef PG8_UB
}
}

__device__ __forceinline__ void transpose_item(const float* W, int N, bf16_t* WT, int ldt, int row_off, int koff, LAS float* scr, int item, int lane) {
    const int nblk = N / 32, kb = item / nblk, nb = item % nblk, k0 = 64 * kb, n0 = 32 * nb;
#pragma unroll 8
    for (int i = 0; i < 32; ++i) { const int kk = 2 * i + (lane >> 5); scr[kk * 33 + (lane & 31)] = W[(size_t)(k0 + kk) * N + n0 + (lane & 31)]; }
    LDS_WAIT(); asm volatile("" ::: "memory");
    const int c = lane & 7;
#pragma unroll
    for (int j = 0; j < 4; ++j) { const int n = (lane >> 3) + 8 * j; const LAS float* s = scr + (8 * c) * 33 + n;
        u32x4 o; o.x = cvt_pk_bf16(s[0 * 33], s[1 * 33]); o.y = cvt_pk_bf16(s[2 * 33], s[3 * 33]); o.z = cvt_pk_bf16(s[4 * 33], s[5 * 33]); o.w = cvt_pk_bf16(s[6 * 33], s[7 * 33]);
        *(u32x4*)(WT + (size_t)(row_off + n0 + n) * ldt + koff + k0 + 8 * c) = o; }
    LDS_WAIT(); asm volatile("" ::: "memory");
}
__device__ __forceinline__ void transpose_matrix(const float* W, int K, int N, bf16_t* WT, int ldt, int row_off, int koff, LAS float* scr, int gw, int NGW, int lane) {
    const int nitems = (K / 64) * (N / 32);
    for (int it = gw; it < nitems; it += NGW) transpose_item(W, N, WT, ldt, row_off, koff, scr, it, lane);
}
__device__ __forceinline__ void convert_rows(const float* src, bf16_t* dst, size_t n, int gtid, int gthreads) {
    for (size_t i = (size_t)gtid * 8; i < n; i += (size_t)gthreads * 8) {
        const f32x4 a = *(const f32x4*)(src + i), b = *(const f32x4*)(src + i + 4);
        u32x4 o; o.x = cvt_pk_bf16(a[0], a[1]); o.y = cvt_pk_bf16(a[2], a[3]); o.z = cvt_pk_bf16(b[0], b[1]); o.w = cvt_pk_bf16(b[2], b[3]);
        *(u32x4*)(dst + i) = o;
    }
}

__device__ __forceinline__ void ln_rows(float* io, bf16_t* xn, const float* gam, const float* bet, int nrows, int gw, int NGW, int lane) {
    f32x4 gv[4], bv[4];
#pragma unroll
    for (int j = 0; j < 4; ++j) { gv[j] = *(const f32x4*)(gam + 4 * lane + 256 * j); bv[j] = *(const f32x4*)(bet + 4 * lane + 256 * j); }
    for (int r = gw; r < nrows; r += NGW) {
        f32x4* xr = (f32x4*)(io + (size_t)r * D) + lane;
        f32x4 v[4]; float s = 0.f;
#pragma unroll
        for (int j = 0; j < 4; ++j) { v[j] = xr[64 * j]; s += (v[j][0] + v[j][1]) + (v[j][2] + v[j][3]); }
        const float mean = wave_sum(s) * (1.f / D); float s2 = 0.f;
#pragma unroll
        for (int j = 0; j < 4; ++j) { v[j] = v[j] - mean; s2 += (v[j][0] * v[j][0] + v[j][1] * v[j][1]) + (v[j][2] * v[j][2] + v[j][3] * v[j][3]); }
        const float rstd = 1.f / sqrtf(wave_sum(s2) * (1.f / D) + LN_EPS);
        u32x2* o8 = (u32x2*)(xn + (size_t)r * D) + lane;
#pragma unroll
        for (int j = 0; j < 4; ++j) { const f32x4 y = v[j] * rstd * gv[j] + bv[j]; xr[64 * j] = y; u32x2 w; w.x = cvt_pk_bf16(y[0], y[1]); w.y = cvt_pk_bf16(y[2], y[3]); o8[64 * j] = w; }
    }
}

__device__ __forceinline__ void conv_phase(const bf16_t* P, bf16_t* Y, const float* cw  , int gtid, int gthreads) {
    constexpr int RUN = 16;
    const int nwork = (RC / RUN) * 64;
    for (int wi = gtid; wi < nwork; wi += gthreads) {
        const int cg8 = wi & 63, run = wi >> 6, c0 = cg8 * 8, r0 = run * RUN;
        float w0[8], w1[8], w2[8];
#pragma unroll
        for (int j = 0; j < 8; ++j) { w0[j] = cw[c0 + j]; w1[j] = cw[512 + c0 + j]; w2[j] = cw[1024 + c0 + j]; }
        float um2[8], um1[8];
        const bool head = (r0 % SEQ) == 0;
#pragma unroll
        for (int j = 0; j < 8; ++j) { um2[j] = 0.f; um1[j] = 0.f; }
        if (!head) {
            const u32x4 c2 = *(const u32x4*)(P + (size_t)(r0 - 2) * INC + C_CC + c0), h2 = *(const u32x4*)(P + (size_t)(r0 - 2) * INC + C_CH + c0);
            const u32x4 c1 = *(const u32x4*)(P + (size_t)(r0 - 1) * INC + C_CC + c0), h1 = *(const u32x4*)(P + (size_t)(r0 - 1) * INC + C_CH + c0);
#pragma unroll
            for (int q = 0; q < 4; ++q) { um2[2 * q] = bflo(c2[q]) * bflo(h2[q]); um2[2 * q + 1] = bfhi(c2[q]) * bfhi(h2[q]); um1[2 * q] = bflo(c1[q]) * bflo(h1[q]); um1[2 * q + 1] = bfhi(c1[q]) * bfhi(h1[q]); }
        }
        for (int t = 0; t < RUN; ++t) {
            const size_t r = (size_t)(r0 + t);
            const u32x4 cc = *(const u32x4*)(P + r * INC + C_CC + c0), ch = *(const u32x4*)(P + r * INC + C_CH + c0), cb = *(const u32x4*)(P + r * INC + C_CB + c0);
            float u[8], y[8];
#pragma unroll
            for (int q = 0; q < 4; ++q) { u[2 * q] = bflo(cc[q]) * bflo(ch[q]); u[2 * q + 1] = bfhi(cc[q]) * bfhi(ch[q]); }
#pragma unroll
            for (int q = 0; q < 4; ++q) { y[2 * q] = bflo(cb[q]) * (w0[2 * q] * um2[2 * q] + w1[2 * q] * um1[2 * q] + w2[2 * q] * u[2 * q]);
                                          y[2 * q + 1] = bfhi(cb[q]) * (w0[2 * q + 1] * um2[2 * q + 1] + w1[2 * q + 1] * um1[2 * q + 1] + w2[2 * q + 1] * u[2 * q + 1]); }
            u32x4 o; o.x = cvt_pk_bf16(y[0], y[1]); o.y = cvt_pk_bf16(y[2], y[3]); o.z = cvt_pk_bf16(y[4], y[5]); o.w = cvt_pk_bf16(y[6], y[7]);
            *(u32x4*)(Y + r * YW + c0) = o;
#pragma unroll
            for (int j = 0; j < 8; ++j) { um2[j] = um1[j]; um1[j] = u[j]; }
        }
    }
}

constexpr int AT_KP = 136, AT_VP = 264, AT_VOFF = 256 * AT_KP * 2;
static_assert(AT_VOFF + 128 * AT_VP * 2 <= LDS_BYTES, "attention LDS");
__device__ __forceinline__ void attn_unit(LAS unsigned char* lds, const bf16_t* P, const bf16_t* MKV  , bf16_t* Y, int chunk, int unit) {
    const int tid = opaque_tid(), w = tid >> 6, lane = tid & 63, c = lane & 15, g = lane >> 4;
    const int qt = unit & 15, h = (unit >> 4) & 3, bl = unit >> 6, b = chunk * BPC + bl;
    LAS bf16_t* KS = (LAS bf16_t*)lds; LAS bf16_t* VT = (LAS bf16_t*)(lds + AT_VOFF);
    __syncthreads();
#pragma unroll
    for (int i = 0; i < 8; ++i) {
        const int key = tid & 255, chn = (tid >> 8) + 2 * i;
        const bf16_t* src = MKV + (size_t)(b * MEML + key) * 4096 + h * 128 + chn * 8;
        const u32x4 kv = *(const u32x4*)src; const u32x4 vv = *(const u32x4*)(src + 512);
        *(LAS u32x4*)(KS + key * AT_KP + chn * 8) = kv;
#pragma unroll
        for (int q = 0; q < 4; ++q) { VT[(chn * 8 + 2 * q) * AT_VP + key] = (bf16_t)(vv[q] & 0xffffu); VT[(chn * 8 + 2 * q + 1) * AT_VP + key] = (bf16_t)(vv[q] >> 16); }
    }
    __syncthreads();
    const float scale = 0.08838834764831845f;
#pragma unroll 1
    for (int pass = 0; pass < 2; ++pass) {
        const size_t qrow0 = (size_t)bl * SEQ + qt * 256 + w * 32 + pass * 16;
        bf16x8 qb[4];
#pragma unroll
        for (int ks = 0; ks < 4; ++ks) qb[ks] = *(const bf16x8*)(P + (qrow0 + c) * INC + C_MQ + h * 128 + ks * 32 + g * 8);
        f32x4 sc[16];
#pragma unroll
        for (int kt = 0; kt < 16; ++kt) {
            sc[kt] = (f32x4){0.f, 0.f, 0.f, 0.f};
#pragma unroll
            for (int ks = 0; ks < 4; ++ks) { const bf16x8 ka = *(const LAS bf16x8*)(KS + (kt * 16 + c) * AT_KP + ks * 32 + g * 8); sc[kt] = __builtin_amdgcn_mfma_f32_16x16x32_bf16(ka, qb[ks], sc[kt], 0, 0, 0); }
            if (kt & 1) asm volatile("" ::: "memory");
        }
        float mx = -3.0e38f;
#pragma unroll
        for (int kt = 0; kt < 16; ++kt) mx = fmaxf(mx, fmaxf(fmaxf(sc[kt][0], sc[kt][1]), fmaxf(sc[kt][2], sc[kt][3])));
        mx = fmaxf(mx, __shfl_xor(mx, 16)); mx = fmaxf(mx, __shfl_xor(mx, 32));
        float sum = 0.f;
#pragma unroll
        for (int kt = 0; kt < 16; ++kt)
#pragma unroll
            for (int r = 0; r < 4; ++r) { const float p = __expf((sc[kt][r] - mx) * scale); sc[kt][r] = p; sum += p; }
        sum += __shfl_xor(sum, 16); sum += __shfl_xor(sum, 32);
        const float rs = 1.0f / sum;
        bf16x8 pa[8];
#pragma unroll
        for (int k2 = 0; k2 < 8; ++k2) {
            u32x4 wv; wv.x = cvt_pk_bf16_c(sc[2 * k2][0] * rs, sc[2 * k2][1] * rs); wv.y = cvt_pk_bf16_c(sc[2 * k2][2] * rs, sc[2 * k2][3] * rs);
            wv.z = cvt_pk_bf16_c(sc[2 * k2 + 1][0] * rs, sc[2 * k2 + 1][1] * rs); wv.w = cvt_pk_bf16_c(sc[2 * k2 + 1][2] * rs, sc[2 * k2 + 1][3] * rs);
            pa[k2] = __builtin_bit_cast(bf16x8, wv);
        }
#pragma unroll
        for (int dt = 0; dt < 8; ++dt) {
            f32x4 o = (f32x4){0.f, 0.f, 0.f, 0.f};
#pragma unroll
            for (int k2 = 0; k2 < 8; ++k2) {
                const s16x4 lo = *(const LAS s16x4*)(VT + (dt * 16 + c) * AT_VP + k2 * 32 + 4 * g), hi = *(const LAS s16x4*)(VT + (dt * 16 + c) * AT_VP + k2 * 32 + 16 + 4 * g);
                const bf16x8 vb = (bf16x8){lo[0], lo[1], lo[2], lo[3], hi[0], hi[1], hi[2], hi[3]};
                o = __builtin_amdgcn_mfma_f32_16x16x32_bf16(pa[k2], vb, o, 0, 0, 0);
            }
#pragma unroll
            for (int r = 0; r < 4; ++r) Y[(qrow0 + 4 * g + r) * YW + 1024 + h * 128 + dt * 16 + c] = f2bf(o[r]);
            asm volatile("" ::: "memory");
        }
    }
}

constexpr int HG_QA = 0, HG_KB = 8704, HG_KBT = 17408, HG_VT = 27648, HG_TOT = 37888, HG_SREF = 39936, HG_SLAST = 40448, HG_SSQ = 40960, HG_P = 136, HG_TP = 40;
template <bool OUT>
__device__ __forceinline__ void hgrn_item(LAS unsigned char* lds, const bf16_t* P, bf16_t* Y, float* Sloc, float* Dloc, const float* lbraw, const float* normw, int layer, int item) {
    const int tid = opaque_tid(), w = tid >> 6, lane = tid & 63, c = lane & 15, g = lane >> 4;
    const int seg = item & (NSEG - 1), h = (item >> 4) & 3, bl = item >> 6;
    const int f = tid & 127, tg = tid >> 7;
    LAS bf16_t* QA = (LAS bf16_t*)(lds + HG_QA); LAS bf16_t* KB = (LAS bf16_t*)(lds + HG_KB); LAS bf16_t* KBT = (LAS bf16_t*)(lds + HG_KBT); LAS bf16_t* VT = (LAS bf16_t*)(lds + HG_VT);
    LAS float* TOT = (LAS float*)(lds + HG_TOT); LAS float* SREF = (LAS float*)(lds + HG_SREF); LAS float* SLAST = (LAS float*)(lds + HG_SLAST); LAS float* SSQ = (LAS float*)(lds + HG_SSQ);
    float lb;
    { const int chn = h * 128 + f; const float l0 = lbraw[chn], l1 = lbraw[512 + chn], l2 = lbraw[1024 + chn], l3 = lbraw[1536 + chn];
      const float mx = fmaxf(fmaxf(l0, l1), fmaxf(l2, l3)); const float e0 = __expf(l0 - mx), e1 = __expf(l1 - mx), e2 = __expf(l2 - mx), e3 = __expf(l3 - mx);
      const float inv = 1.0f / (e0 + e1 + e2 + e3);
      lb = (layer == 0) ? 0.f : ((layer == 1) ? e1 : ((layer == 2) ? (e1 + e2) : (e1 + e2 + e3))) * inv; }
    const float oml = 1.0f - lb;
    f32x4 S[8];
#pragma unroll
    for (int ft = 0; ft < 8; ++ft) S[ft] = (f32x4){0.f, 0.f, 0.f, 0.f};
    const int ibase = (bl * 4 + h) * NSEG;
    if (OUT) {
        for (int m = 0; m < seg; ++m) {
            const float* sl = Sloc + (size_t)(ibase + m) * 16384; const float* dl = Dloc + (size_t)(ibase + m) * 128;
#pragma unroll
            for (int ft = 0; ft < 8; ++ft) { const f32x4 dd = *(const f32x4*)(dl + 16 * ft + 4 * g);
#pragma unroll
                for (int j = 0; j < 4; ++j) S[ft][j] = S[ft][j] * dd[j] + sl[(size_t)(16 * ft + 4 * g + j) * 128 + 16 * w + c]; }
        }
    }
    const size_t row0 = (size_t)bl * SEQ + (size_t)seg * HSEG;
    float btot = 0.f;
    __syncthreads();
#pragma unroll 1
    for (int ck = 0; ck < HSEG / 32; ++ck) {
        const size_t rb = row0 + ck * 32 + tg * 8;
        float cs[8], qs[8], kk[8]; unsigned short vraw[8];
#pragma unroll
        for (int e = 0; e < 8; ++e) {
            const bf16_t* pr = P + (rb + e) * INC + h * 128 + f;
            float fl = bf2f(pr[C_HF]); const float qv = bf2f(pr[C_HQ]); vraw[e] = pr[C_HI];
            fl = fminf(fmaxf(fl, -30.f), 30.f);
            const float ex = __expf(-fl), sg = 1.0f / (1.0f + ex);
            cs[e] = __logf(lb + oml * sg); kk[e] = oml * ex * sg; qs[e] = qv * sigmoidf_(qv);
        }
#pragma unroll
        for (int e = 1; e < 8; ++e) cs[e] += cs[e - 1];
        TOT[tg * 128 + f] = cs[7];
        __syncthreads();
        const float t0 = TOT[f], t1 = TOT[128 + f], t2 = TOT[256 + f], t3 = TOT[384 + f];
        const float off = (tg > 0 ? t0 : 0.f) + (tg > 1 ? t1 : 0.f) + (tg > 2 ? t2 : 0.f);
        const float bref = t0 + t1, blast = (t0 + t1) + (t2 + t3);
        btot += blast;
        unsigned short kbr[8];
#pragma unroll
        for (int e = 0; e < 8; ++e) {
            const float bc = off + cs[e];
            const float qa = qs[e] * __expf(bc - bref), kb = kk[e] * __expf(bref - bc);
            QA[(tg * 8 + e) * HG_P + f] = f2bf(qa); kbr[e] = f2bf(kb); KB[(tg * 8 + e) * HG_P + f] = kbr[e];
        }
        { u32x4 wv; wv.x = kbr[0] | ((unsigned)kbr[1] << 16); wv.y = kbr[2] | ((unsigned)kbr[3] << 16); wv.z = kbr[4] | ((unsigned)kbr[5] << 16); wv.w = kbr[6] | ((unsigned)kbr[7] << 16);
          *(LAS u32x4*)(KBT + f * HG_TP + tg * 8) = wv;
          u32x4 vv; vv.x = vraw[0] | ((unsigned)vraw[1] << 16); vv.y = vraw[2] | ((unsigned)vraw[3] << 16); vv.z = vraw[4] | ((unsigned)vraw[5] << 16); vv.w = vraw[6] | ((unsigned)vraw[7] << 16);
          *(LAS u32x4*)(VT + f * HG_TP + tg * 8) = vv; }
        if (tg == 0) { SREF[f] = __expf(bref); SLAST[f] = __expf(blast - bref); }
        __syncthreads();
#pragma unroll
        for (int ft = 0; ft < 8; ++ft) { const f32x4 sr = *(const LAS f32x4*)(SREF + 16 * ft + 4 * g); S[ft] = S[ft] * sr; }
        f32x4 O0 = (f32x4){0.f, 0.f, 0.f, 0.f}, O1 = O0;
        if (OUT) {
            f32x4 sc00 = (f32x4){0.f, 0.f, 0.f, 0.f}, sc01 = sc00, sc11 = sc00;
#pragma unroll
            for (int ks = 0; ks < 4; ++ks) {
                const bf16x8 kb0 = *(const LAS bf16x8*)(KB + c * HG_P + ks * 32 + g * 8), kb1 = *(const LAS bf16x8*)(KB + (16 + c) * HG_P + ks * 32 + g * 8);
                const bf16x8 qa0 = *(const LAS bf16x8*)(QA + c * HG_P + ks * 32 + g * 8), qa1 = *(const LAS bf16x8*)(QA + (16 + c) * HG_P + ks * 32 + g * 8);
                sc00 = __builtin_amdgcn_mfma_f32_16x16x32_bf16(kb0, qa0, sc00, 0, 0, 0);
                sc01 = __builtin_amdgcn_mfma_f32_16x16x32_bf16(kb0, qa1, sc01, 0, 0, 0);
                sc11 = __builtin_amdgcn_mfma_f32_16x16x32_bf16(kb1, qa1, sc11, 0, 0, 0);
            }
#pragma unroll
            for (int r = 0; r < 4; ++r) { if (4 * g + r > c) { sc00[r] = 0.f; sc11[r] = 0.f; } }
            u32x4 p0w, p1w;
            p0w.x = cvt_pk_bf16_c(sc00[0], sc00[1]); p0w.y = cvt_pk_bf16_c(sc00[2], sc00[3]); p0w.z = 0u; p0w.w = 0u;
            p1w.x = cvt_pk_bf16_c(sc01[0], sc01[1]); p1w.y = cvt_pk_bf16_c(sc01[2], sc01[3]); p1w.z = cvt_pk_bf16_c(sc11[0], sc11[1]); p1w.w = cvt_pk_bf16_c(sc11[2], sc11[3]);
            const s16x4 vlo = *(const LAS s16x4*)(VT + (16 * w + c) * HG_TP + 4 * g), vhi = *(const LAS s16x4*)(VT + (16 * w + c) * HG_TP + 16 + 4 * g);
            const bf16x8 vb = (bf16x8){vlo[0], vlo[1], vlo[2], vlo[3], vhi[0], vhi[1], vhi[2], vhi[3]};
            O0 = __builtin_amdgcn_mfma_f32_16x16x32_bf16(__builtin_bit_cast(bf16x8, p0w), vb, O0, 0, 0, 0);
            O1 = __builtin_amdgcn_mfma_f32_16x16x32_bf16(__builtin_bit_cast(bf16x8, p1w), vb, O1, 0, 0, 0);
#pragma unroll
            for (int ks = 0; ks < 4; ++ks) {
                const s16x4 q0l = *(const LAS s16x4*)(QA + c * HG_P + ks * 32 + 4 * g), q0h = *(const LAS s16x4*)(QA + c * HG_P + ks * 32 + 16 + 4 * g);
                const s16x4 q1l = *(const LAS s16x4*)(QA + (16 + c) * HG_P + ks * 32 + 4 * g), q1h = *(const LAS s16x4*)(QA + (16 + c) * HG_P + ks * 32 + 16 + 4 * g);
                const bf16x8 qa0 = (bf16x8){q0l[0], q0l[1], q0l[2], q0l[3], q0h[0], q0h[1], q0h[2], q0h[3]};
                const bf16x8 qa1 = (bf16x8){q1l[0], q1l[1], q1l[2], q1l[3], q1h[0], q1h[1], q1h[2], q1h[3]};
                u32x4 sw; sw.x = cvt_pk_bf16_c(S[2 * ks][0], S[2 * ks][1]); sw.y = cvt_pk_bf16_c(S[2 * ks][2], S[2 * ks][3]); sw.z = cvt_pk_bf16_c(S[2 * ks + 1][0], S[2 * ks + 1][1]); sw.w = cvt_pk_bf16_c(S[2 * ks + 1][2], S[2 * ks + 1][3]);
                const bf16x8 sb = __builtin_bit_cast(bf16x8, sw);
                O0 = __builtin_amdgcn_mfma_f32_16x16x32_bf16(qa0, sb, O0, 0, 0, 0);
                O1 = __builtin_amdgcn_mfma_f32_16x16x32_bf16(qa1, sb, O1, 0, 0, 0);
            }
        }
        { const bf16x8 vb2 = *(const LAS bf16x8*)(VT + (16 * w + c) * HG_TP + 8 * g);
#pragma unroll
          for (int ft = 0; ft < 8; ++ft) {
              const bf16x8 ka = *(const LAS bf16x8*)(KBT + (16 * ft + c) * HG_TP + 8 * g);
              S[ft] = __builtin_amdgcn_mfma_f32_16x16x32_bf16(ka, vb2, S[ft], 0, 0, 0);
              const f32x4 sl = *(const LAS f32x4*)(SLAST + 16 * ft + 4 * g); S[ft] = S[ft] * sl;
          } }
        if (OUT) {
            float q0[4], q1[4];
#pragma unroll
            for (int r = 0; r < 4; ++r) { q0[r] = O0[r] * O0[r]; q1[r] = O1[r] * O1[r]; }
#pragma unroll
            for (int o = 1; o < 16; o <<= 1)
#pragma unroll
                for (int r = 0; r < 4; ++r) { q0[r] += __shfl_xor(q0[r], o); q1[r] += __shfl_xor(q1[r], o); }
            if (c == 0) {
#pragma unroll
                for (int r = 0; r < 4; ++r) { SSQ[w * 32 + 4 * g + r] = q0[r]; SSQ[w * 32 + 16 + 4 * g + r] = q1[r]; } }
            __syncthreads();
            const int v = 16 * w + c; const float nw = normw[v];
#pragma unroll
            for (int tt = 0; tt < 2; ++tt)
#pragma unroll
                for (int r = 0; r < 4; ++r) {
                    const int t = 16 * tt + 4 * g + r; float tot = 0.f;
#pragma unroll
                    for (int ww = 0; ww < 8; ++ww) tot += SSQ[ww * 32 + t];
                    const float rinv = 1.0f / sqrtf(tot * (1.0f / 128.0f) + RMS_EPS);
                    const size_t row = row0 + ck * 32 + t;
                    const float gv = bf2f(P[row * INC + C_HG + h * 128 + v]);
                    const float ov = (tt == 0 ? O0[r] : O1[r]) * rinv * nw * (gv * sigmoidf_(gv));
                    Y[row * YW + 512 + h * 128 + v] = f2bf(ov);
                }
        }
    }
    if (!OUT) {
        float* sl = Sloc + (size_t)(ibase + seg) * 16384;
#pragma unroll
        for (int ft = 0; ft < 8; ++ft)
#pragma unroll
            for (int j = 0; j < 4; ++j) sl[(size_t)(16 * ft + 4 * g + j) * 128 + 16 * w + c] = S[ft][j];
        if (tg == 0) Dloc[(size_t)(ibase + seg) * 128 + f] = __expf(btot);
    }
    __syncthreads();
}

struct Args { const float* in[17]; float* out; unsigned char* ws; int coop, ph; };
__global__ void __launch_bounds__(512, 2) mega_fwd(Args args) {
    extern __shared__ __attribute__((aligned(16))) unsigned char lds_raw[];
    LAS unsigned char* lds = (LAS unsigned char*)lds_raw;
    cg::grid_group grid = cg::this_grid();
    const int G = gridDim.x, bx = blockIdx.x, NGW = G * 8, gthreads = G * 512;
#define PH_VARS const int tid = opaque_tid(), lane = tid & 63, wave = __builtin_amdgcn_readfirstlane(tid >> 6), gw = bx * 8 + wave, gtid = bx * 512 + tid; (void)lane; (void)gw; (void)gtid
    const float *x = args.in[0], *mem = args.in[1], *lbraw = args.in[2], *w_in = args.in[3], *conv_w = args.in[4], *hg_norm_w = args.in[5], *w_mem_k = args.in[6], *w_mem_v = args.in[7],
                *w_branch = args.in[8], *b_gate = args.in[9], *w_o = args.in[10], *ln1_g = args.in[11], *ln1_b = args.in[12], *w_up = args.in[13], *w_down = args.in[14], *ln2_g = args.in[15], *ln2_b = args.in[16];
    unsigned char* ws = args.ws; float* out = args.out;
    bf16_t *WinT = (bf16_t*)(ws + WS_WIN), *WkvT = (bf16_t*)(ws + WS_WKV), *WbT = (bf16_t*)(ws + WS_WB), *WoT = (bf16_t*)(ws + WS_WO), *WupT = (bf16_t*)(ws + WS_WUP), *WdnT = (bf16_t*)(ws + WS_WDN);
    bf16_t *XN = (bf16_t*)(ws + WS_XN), *MEMB = (bf16_t*)(ws + WS_MEMB), *MKV = (bf16_t*)(ws + WS_MKV), *Y = (bf16_t*)(ws + WS_Y), *MG = (bf16_t*)(ws + WS_MG), *PROJ = (bf16_t*)(ws + WS_PROJ), *HB = (bf16_t*)(ws + WS_H);
    float *Sloc = (float*)(ws + WS_SLOC), *Dloc = (float*)(ws + WS_DLOC);
    int pid = 0;
#define PHASE_IF if (args.coop || pid == args.ph)
#define PHASE_END do { if (args.coop) grid.sync(); ++pid; } while (0)

    PHASE_IF {
        PH_VARS;
        LAS float* scr = (LAS float*)(lds + wave * 16384);
        for (int l = 0; l < DEPTH; ++l) {
            transpose_matrix(w_in + (size_t)l * D * INC, D, INC, WinT + (size_t)l * INC * D, D, 0, 0, scr, gw, NGW, lane);
            transpose_matrix(w_mem_k + (size_t)l * D * 512, D, 512, WkvT, D, l * 1024, 0, scr, gw, NGW, lane);
            transpose_matrix(w_mem_v + (size_t)l * D * 512, D, 512, WkvT, D, l * 1024 + 512, 0, scr, gw, NGW, lane);
            for (int j = 0; j < 3; ++j) transpose_matrix(w_branch + ((size_t)l * 3 + j) * 512 * D, 512, D, WbT + (size_t)l * D * YW, YW, 0, j * 512, scr, gw, NGW, lane);
            transpose_matrix(w_o + (size_t)l * D * D, D, D, WoT + (size_t)l * D * D, D, 0, 0, scr, gw, NGW, lane);
            transpose_matrix(w_up + (size_t)l * D * FF, D, FF, WupT + (size_t)l * FF * D, D, 0, 0, scr, gw, NGW, lane);
            transpose_matrix(w_down + (size_t)l * FF * D, FF, D, WdnT + (size_t)l * D * FF, FF, 0, 0, scr, gw, NGW, lane);
        }
        convert_rows(x, XN, (size_t)M * D, gtid, gthreads);
        convert_rows(mem, MEMB, (size_t)NBATCH * MEML * D, gtid, gthreads);
        __syncthreads();
    }
    PHASE_END;
    PHASE_IF {
        pg8::Gemm gm{MEMB, WkvT, D, D, D}; pg8::Order S; S.init(16, 16, G, bx, 1);
        pg8::EpiStore<0> E{MKV, 4096, nullptr};

#ifndef NO_G_MKV
                pg8::gemm_phase(lds, gm, S, E);
#endif

    }
    PHASE_END;
    for (int l = 0; l < DEPTH; ++l) {
        for (int ch = 0; ch < NCH; ++ch) {
            const size_t crow = (size_t)ch * RC;
            PHASE_IF {
                pg8::Gemm gm{XN + crow * D, WinT + (size_t)l * INC * D, D, D, D}; pg8::Order S; S.init(RC / 256, INC / 256, G, bx, 1);
                pg8::EpiStore<1> E{PROJ, INC, b_gate + (size_t)l * 3 * D};

#ifndef NO_G_INP
                pg8::gemm_phase(lds, gm, S, E);
#endif

            }
            PHASE_END;
            PHASE_IF {
                #ifndef NO_HG1
                for (int it = bx; it < BPC * 4 * NSEG; it += G) hgrn_item<false>(lds, PROJ, Y, Sloc, Dloc, lbraw, hg_norm_w + l * 128, l, it);
#endif
#ifndef NO_ATT
                for (int u = bx; u < BPC * 4 * 16; u += G) attn_unit(lds, PROJ, MKV + l * 1024, Y, ch, u);
#endif
#ifndef NO_CONV
                { PH_VARS; conv_phase(PROJ, Y, conv_w + (size_t)l * 3 * 512, gtid, gthreads); }
#endif
                __syncthreads();
            }
            PHASE_END;
            PHASE_IF {
#ifndef NO_HG3
                for (int it = bx; it < BPC * 4 * NSEG; it += G) hgrn_item<true>(lds, PROJ, Y, Sloc, Dloc, lbraw, hg_norm_w + l * 128, l, it);
#endif
            }
            PHASE_END;
            PHASE_IF {
                pg8::Gemm gm{Y, WbT + (size_t)l * D * YW, YW, YW, 512}; pg8::Order S; S.init(RC / 256, D / 256, G, bx, 3);
                pg8::EpiGate E{PROJ, MG};

#ifndef NO_G_BR
                pg8::gemm_phase(lds, gm, S, E);
#endif

            }
            PHASE_END;
            PHASE_IF {
                pg8::Gemm gm{MG, WoT + (size_t)l * D * D, D, D, D}; pg8::Order S; S.init(RC / 256, D / 256, G, bx, 1);
                pg8::EpiRes E{(l == 0 ? x : out) + crow * D, out + crow * D};

#ifndef NO_G_WO
                pg8::gemm_phase(lds, gm, S, E);
#endif

            }
            PHASE_END;
            PHASE_IF { PH_VARS; ln_rows(out + crow * D, XN + crow * D, ln1_g + l * D, ln1_b + l * D, RC, gw, NGW, lane); }
            PHASE_END;
            PHASE_IF {
                pg8::Gemm gm{XN + crow * D, WupT + (size_t)l * FF * D, D, D, D}; pg8::Order S; S.init(RC / 256, FF / 256, G, bx, 1);
                pg8::EpiStore<2> E{HB, FF, nullptr};

#ifndef NO_G_UP
                pg8::gemm_phase(lds, gm, S, E);
#endif

            }
            PHASE_END;
            PHASE_IF {
                pg8::Gemm gm{HB, WdnT + (size_t)l * D * FF, FF, FF, FF}; pg8::Order S; S.init(RC / 256, D / 256, G, bx, 1);
                pg8::EpiRes E{out + crow * D, out + crow * D};

#ifndef NO_G_DN
                pg8::gemm_phase(lds, gm, S, E);
#endif

            }
            PHASE_END;
            PHASE_IF { PH_VARS; ln_rows(out + crow * D, XN + crow * D, ln2_g + l * D, ln2_b + l * D, RC, gw, NGW, lane); }
            PHASE_END;
        }
    }
}

constexpr int N_PHASES = 2 + DEPTH * NCH * 10;

extern "C" void kernel_launch(void* const* d_in, const int* in_sizes, int n_in, void* d_out, int out_size, void* d_ws, size_t ws_size, hipStream_t stream) {
    static int grid = 0;
    if (grid == 0) {
        if (n_in != 17 || in_sizes[0] != M * D || out_size != M * D || ws_size < WS_END) { fprintf(stderr, "kernel_launch: unexpected shapes / workspace (n_in %d, ws %zu, need %zu)\n", n_in, ws_size, (size_t)WS_END); grid = -1; return; }
        int dev = 0, cus = 0, per_cu = 0;
        if (hipGetDevice(&dev) != hipSuccess || hipDeviceGetAttribute(&cus, hipDeviceAttributeMultiprocessorCount, dev) != hipSuccess) { grid = -1; return; }
        if (hipFuncSetAttribute((const void*)mega_fwd, hipFuncAttributeMaxDynamicSharedMemorySize, LDS_BYTES) != hipSuccess) { fprintf(stderr, "kernel_launch: hipFuncSetAttribute failed\n"); grid = -1; return; }
        if (hipOccupancyMaxActiveBlocksPerMultiprocessor(&per_cu, (const void*)mega_fwd, 512, LDS_BYTES) != hipSuccess || per_cu < 1) { fprintf(stderr, "kernel_launch: occupancy query says %d\n", per_cu); per_cu = 1; }
        (void)hipGetLastError();
        grid = cus * 1;
    }
    if (grid < 0) return;
    Args a{};
    for (int i = 0; i < 17; ++i) a.in[i] = (const float*)d_in[i];
    a.out = (float*)d_out; a.ws = (unsigned char*)d_ws; a.coop = 1; a.ph = 0;
    void* kargs[] = {&a};
    hipError_t e = hipLaunchCooperativeKernel((const void*)mega_fwd, dim3(grid), dim3(512), kargs, LDS_BYTES, stream);
    if (e != hipSuccess) fprintf(stderr, "kernel_launch: cooperative launch failed: %s (grid %d)\n", hipGetErrorString(e), grid);
}
```

```cpp
#include <hip/hip_runtime.h>
#include <hip/hip_cooperative_groups.h>
#include <cstdio>
#include <cstdint>
namespace cg = cooperative_groups;

#define LAS __attribute__((address_space(3)))
typedef unsigned short bf16_t;
typedef short bf16x8 __attribute__((ext_vector_type(8)));
typedef short s16x4 __attribute__((ext_vector_type(4)));
typedef float f32x4 __attribute__((ext_vector_type(4)));
typedef unsigned u32x4 __attribute__((ext_vector_type(4)));
typedef unsigned u32x2 __attribute__((ext_vector_type(2)));

constexpr int M = 65536, D = 1024, INC = 7168, FF = 4096, SEQ = 4096, NBATCH = 16, MEML = 256, DEPTH = 4;
constexpr int RC = 32768, NCH = M / RC, BPC = RC / SEQ;
constexpr int YW = 1536;
constexpr int C_CB = 0, C_CC = 512, C_CH = 1024, C_HQ = 1536, C_HF = 2048, C_HI = 2560, C_HG = 3072, C_MQ = 3584, C_G = 4096;
constexpr float ALPHA = 1.6817928305074292f, LN_EPS = 1e-5f, RMS_EPS = 1e-6f;
constexpr int HSEG = 256, NSEG = SEQ / HSEG;

constexpr size_t MiB = 1u << 20;
constexpr size_t WS_WIN = 0, WS_WKV = 56 * MiB, WS_WB = 64 * MiB, WS_WO = 76 * MiB, WS_WUP = 84 * MiB, WS_WDN = 116 * MiB;
constexpr size_t WS_XN = 148 * MiB, WS_MEMB = 276 * MiB, WS_MKV = 284 * MiB, WS_Y = 316 * MiB, WS_MG = 412 * MiB;
constexpr size_t WS_SLOC = 476 * MiB, WS_DLOC = 508 * MiB, WS_PROJ = 512 * MiB, WS_H = WS_PROJ, WS_CTL = 960 * MiB, WS_END = 961 * MiB;
static_assert(WS_PROJ + (size_t)RC * INC * 2 <= WS_CTL && WS_H + (size_t)RC * FF * 2 <= WS_CTL, "ws map");
static_assert((size_t)BPC * 4 * NSEG * 128 * 128 * 4 <= WS_DLOC - WS_SLOC, "ws map");

constexpr int LDS_BYTES = 147456;

typedef float f32x2_t __attribute__((ext_vector_type(2))); typedef __bf16 bf16x2_t __attribute__((ext_vector_type(2)));
__device__ __forceinline__ unsigned cvt_pk_bf16_c(float lo, float hi) { f32x2_t v = {lo, hi}; bf16x2_t b = __builtin_convertvector(v, bf16x2_t); return __builtin_bit_cast(unsigned, b); }
__device__ __forceinline__ unsigned cvt_pk_bf16(float lo, float hi) { unsigned r; asm volatile("v_cvt_pk_bf16_f32 %0, %1, %2" : "=v"(r) : "v"(lo), "v"(hi)); return r; }
__device__ __forceinline__ unsigned short f2bf(float f) { return (unsigned short)(cvt_pk_bf16_c(f, 0.f) & 0xffffu); }
__device__ __forceinline__ float bf2f(unsigned short b) { return __uint_as_float((unsigned)b << 16); }
__device__ __forceinline__ float bflo(unsigned w) { return __uint_as_float(w << 16); }
__device__ __forceinline__ float bfhi(unsigned w) { return __uint_as_float(w & 0xffff0000u); }
__device__ __forceinline__ float sigmoidf_(float x) { return 1.0f / (1.0f + __expf(-x)); }
__device__ __forceinline__ float wave_sum(float v) {
#pragma unroll
    for (int o = 1; o < 64; o <<= 1) v += __shfl_xor(v, o);
    return v;
}
#define LDS_WAIT() asm volatile("s_waitcnt lgkmcnt(0)" ::: "memory")
__device__ __forceinline__ int opaque_tid() { int t = threadIdx.x; asm volatile("" : "+v"(t)); return t; }

namespace pg8 {
constexpr int BM = 256, BK = 64, HALF = 128, HTB = HALF * BK * 2, STAGE_BYTES = 8 * HTB, NXCD = 8, WGM = 8;
__device__ __forceinline__ int lds_byte(int r, int c) { const int st = (r >> 4) * 2 + (c >> 5), rr = r & 15, cc = c & 31, ob = rr * 64 + cc * 2; return st * 1024 + (ob ^ (((ob >> 9) & 1) << 5)); }
__device__ __forceinline__ void stage_rc(int b, int& R, int& C) { const int st = b / 1024, sb = b % 1024, swz = sb ^ (((sb >> 9) & 1) << 5); R = (st >> 1) * 16 + swz / 64; C = (st & 1) * 32 + (swz % 64) / 2; }
__device__ __forceinline__ int perm32(int rho) { const int n = rho >> 4, i = rho & 15; return 8 * (i >> 2) + 4 * n + (i & 3); }

struct Unit { int pm, pn, sub; };
struct Gemm { const bf16_t* A; const bf16_t* Bt; int lda, ldb, K; };

struct Order {
    int nM, nN, nwg, G, c, nsub;
    __device__ __forceinline__ void init(int nM_, int nN_, int G_, int c_, int nsub_) { nM = nM_; nN = nN_; nwg = nM * nN; G = G_; c = c_; nsub = nsub_; }
    __device__ __forceinline__ bool next(int i, Unit& u) const {
        const int ti = i / nsub; u.sub = i - ti * nsub;
        const long L = (long)ti * G + c; if (L >= nwg) return false;
        int wgid = (int)L; { const int q = nwg / NXCD, r = nwg % NXCD, xcd = wgid % NXCD, off = wgid / NXCD; wgid = (xcd < r ? xcd * (q + 1) : r * (q + 1) + (xcd - r) * q) + off; }
        const int nig = WGM * nN, gid = wgid / nig, fm = gid * WGM, gsz = (nM - fm) < WGM ? (nM - fm) : WGM;
        u.pm = fm + ((wgid % nig) % gsz); u.pn = (wgid % nig) / gsz; return true;
    }
};

template <int MODE> struct EpiStore {
    static constexpr bool PERM = true;
    bf16_t* O; int ldc; const float* bias;
    __device__ __forceinline__ bool keep(const Unit&) const { return false; }
    __device__ __forceinline__ void operator()(f32x4 (&acc)[2][2][4][2], const Unit& u, int wr, int wc, int fr, int fq) const {
        const int row0 = u.pm * BM + wr * 64 + fr; const int col0 = u.pn * BM + wc * 32 + 8 * fq;
        const bool gate = (MODE == 1) && (u.pn * BM >= C_G);
#pragma unroll
        for (int bj = 0; bj < 2; ++bj) {
            f32x4 b0 = (f32x4){0.f, 0.f, 0.f, 0.f}, b1 = b0;
            if (MODE == 1) { if (gate) { b0 = *(const f32x4*)(bias + col0 - C_G + bj * HALF); b1 = *(const f32x4*)(bias + col0 - C_G + bj * HALF + 4); } }
#pragma unroll
            for (int ai = 0; ai < 2; ++ai)
#pragma unroll
                for (int m = 0; m < 4; ++m) {
                    bf16_t* rowp = O + (size_t)(row0 + ai * HALF + m * 16) * ldc + col0 + bj * HALF;
                    f32x4 v0 = acc[ai][bj][m][0], v1 = acc[ai][bj][m][1];
                    if (MODE == 1) { if (gate) {
#pragma unroll
                        for (int j = 0; j < 4; ++j) { v0[j] = sigmoidf_(v0[j] + b0[j]); v1[j] = sigmoidf_(v1[j] + b1[j]); } } }
                    if (MODE == 2) {
#pragma unroll
                        for (int j = 0; j < 4; ++j) { const float a = fmaxf(v0[j], 0.f), b = fmaxf(v1[j], 0.f); v0[j] = a * a; v1[j] = b * b; } }
                    u32x4 w; w.x = cvt_pk_bf16(v0[0], v0[1]); w.y = cvt_pk_bf16(v0[2], v0[3]); w.z = cvt_pk_bf16(v1[0], v1[1]); w.w = cvt_pk_bf16(v1[2], v1[3]);
                    *(u32x4*)rowp = w;
                    asm volatile("" ::: "memory");
                }
        }
    }
};
struct EpiGate {
    static constexpr bool PERM = true;
    const bf16_t* P; bf16_t* O;
    __device__ __forceinline__ bool keep(const Unit& u) const { return u.sub < 2; }
    __device__ __forceinline__ void operator()(f32x4 (&acc)[2][2][4][2], const Unit& u, int wr, int wc, int fr, int fq) const {
        const int row0 = u.pm * BM + wr * 64 + fr; const int col0 = u.pn * BM + wc * 32 + 8 * fq;
        const bool last = (u.sub == 2);
#pragma unroll
        for (int ai = 0; ai < 2; ++ai)
#pragma unroll
            for (int m = 0; m < 4; ++m) {
                const size_t row = (size_t)(row0 + ai * HALF + m * 16);
#pragma unroll
                for (int bj = 0; bj < 2; ++bj) {
                    const bf16_t* gp = P + row * INC + C_G + u.sub * 1024 + col0 + bj * HALF;
                    const u32x4 ga = *(const u32x4*)gp;
                    float s[8] = {bflo(ga.x), bfhi(ga.x), bflo(ga.y), bfhi(ga.y), bflo(ga.z), bfhi(ga.z), bflo(ga.w), bfhi(ga.w)};
                    if (!last) {
                        const u32x4 gb = *(const u32x4*)(gp + 1024);
                        const float t[8] = {bflo(gb.x), bfhi(gb.x), bflo(gb.y), bfhi(gb.y), bflo(gb.z), bfhi(gb.z), bflo(gb.w), bfhi(gb.w)};
#pragma unroll
                        for (int j = 0; j < 8; ++j) s[j] = s[j] * __builtin_amdgcn_rcpf(fmaxf(t[j], 1e-30f));
                    }
                    f32x4 v0 = acc[ai][bj][m][0], v1 = acc[ai][bj][m][1];
#pragma unroll
                    for (int j = 0; j < 4; ++j) { v0[j] *= s[j]; v1[j] *= s[4 + j]; }
                    if (last) {
                        u32x4 w; w.x = cvt_pk_bf16(v0[0], v0[1]); w.y = cvt_pk_bf16(v0[2], v0[3]); w.z = cvt_pk_bf16(v1[0], v1[1]); w.w = cvt_pk_bf16(v1[2], v1[3]);
                        *(u32x4*)(O + row * D + col0 + bj * HALF) = w;
                    } else { acc[ai][bj][m][0] = v0; acc[ai][bj][m][1] = v1; }
                    asm volatile("" ::: "memory");
                }
            }
    }
};
struct EpiRes {
    static constexpr bool PERM = false;
    const float* base; float* out;
    __device__ __forceinline__ bool keep(const Unit&) const { return false; }
    __device__ __forceinline__ void operator()(f32x4 (&acc)[2][2][4][2], const Unit& u, int wr, int wc, int fr, int fq) const {
        const int row0 = u.pm * BM + wr * 64 + fr; const int col0 = u.pn * BM + wc * 32 + 4 * fq;
#pragma unroll
        for (int ai = 0; ai < 2; ++ai)
#pragma unroll
            for (int m = 0; m < 4; ++m) {
                const size_t off = (size_t)(row0 + ai * HALF + m * 16) * D + col0;
#pragma unroll
                for (int bj = 0; bj < 2; ++bj)
#pragma unroll
                    for (int n = 0; n < 2; ++n) { const f32x4 b = *(const f32x4*)(base + off + bj * HALF + n * 16); *(f32x4*)(out + off + bj * HALF + n * 16) = b * ALPHA + acc[ai][bj][m][n]; }
                asm volatile("" ::: "memory");
            }
    }
};

template <class Epi>
__device__ __forceinline__ void gemm_phase(LAS unsigned char* lds, const Gemm g, const Order& S, const Epi& E) {
    const int tid = opaque_tid(), wid = __builtin_amdgcn_readfirstlane(tid >> 6), lane = tid & 63, wr = wid >> 2, wc = wid & 3, fr = lane & 15, fq = lane >> 4;
    const int K = g.K, nt = K / BK;
    unsigned voffA[2], voffB[2];
#pragma unroll
    for (int i = 0; i < 2; ++i) { int R, C; stage_rc(tid * 16 + i * 8192, R, C); const int Rb = Epi::PERM ? ((R & ~31) + perm32(R & 31)) : R;
        voffA[i] = (unsigned)(R * g.lda + C) * 2u; voffB[i] = (unsigned)(Rb * g.ldb + C) * 2u; }
    const size_t kstep = (size_t)(BK * 2);
    const size_t hA = (size_t)HALF * g.lda * 2, hB = (size_t)HALF * g.ldb * 2, tA = 2 * hA, tB = 2 * hB;
    const unsigned ldsw = (unsigned)wid * 1024u;
    const int aoff = lds_byte(wr * 64 + fr, fq * 8), boff = lds_byte(wc * 32 + fr, fq * 8);
#define PG8_SA(b, h) (((b) * 2 + (h)) * HTB)
#define PG8_SB(b, h) ((4 + (b) * 2 + (h)) * HTB)
#define PG8_STAGE(bufoff, gbase, voff) do { _Pragma("unroll") for (int _i = 0; _i < 2; ++_i) \
        __builtin_amdgcn_global_load_lds((const unsigned*)((const char*)(gbase) + (voff)[_i]), (LAS unsigned*)(lds + (bufoff) + ldsw + _i * 8192), 16, 0, 0); } while (0)
#define PG8_LDA(dst, b, h) do { _Pragma("unroll") for (int m = 0; m < 4; ++m) _Pragma("unroll") for (int k = 0; k < 2; ++k) dst[m][k] = *(const LAS bf16x8*)(lds + PG8_SA(b, h) + aoff + m * 2048 + k * 1024); } while (0)
#define PG8_LDB(dst, b, h) do { _Pragma("unroll") for (int n = 0; n < 2; ++n) _Pragma("unroll") for (int k = 0; k < 2; ++k) dst[n][k] = *(const LAS bf16x8*)(lds + PG8_SB(b, h) + boff + n * 2048 + k * 1024); } while (0)
#define PG8_MMA(ai, bj, At, Bt) do { __builtin_amdgcn_s_setprio(1); _Pragma("unroll") for (int m = 0; m < 4; ++m) _Pragma("unroll") for (int n = 0; n < 2; ++n) _Pragma("unroll") for (int k = 0; k < 2; ++k) \
        acc[ai][bj][m][n] = __builtin_amdgcn_mfma_f32_16x16x32_bf16(Bt[n][k], At[m][k], acc[ai][bj][m][n], 0, 0, 0); __builtin_amdgcn_s_setprio(0); } while (0)
#define PG8_WAIT_V(n) asm volatile("s_waitcnt vmcnt(" #n ")" ::: "memory")
#define PG8_WAIT_L(n) asm volatile("s_waitcnt lgkmcnt(" #n ")" ::: "memory")
#define PG8_BAR __builtin_amdgcn_s_barrier()
#define PG8_SCHED __builtin_amdgcn_sched_barrier(0)
#define PG8_UA(u) ((const char*)g.A + (size_t)(u).pm * tA + (size_t)(u).sub * K * 2)
#define PG8_UB(u) ((const char*)g.Bt + (size_t)(u).pn * tB + (size_t)(u).sub * K * 2)
    Unit cur, nxt; int ui = 0;
    if (!S.next(0, cur)) return;
    f32x4 acc[2][2][4][2];
#pragma unroll
    for (int a = 0; a < 2; ++a)
#pragma unroll
        for (int b = 0; b < 2; ++b)
#pragma unroll
            for (int m = 0; m < 4; ++m)
#pragma unroll
                for (int n = 0; n < 2; ++n) acc[a][b][m][n] = (f32x4){0.f, 0.f, 0.f, 0.f};
    bf16x8 At[4][2], B0[2][2], B1[2][2];
    const char* cA = PG8_UA(cur); const char* cB = PG8_UB(cur);
    PG8_STAGE(PG8_SB(0, 0), cB, voffB); PG8_STAGE(PG8_SB(0, 1), cB + hB, voffB); PG8_STAGE(PG8_SA(0, 0), cA, voffA); PG8_STAGE(PG8_SA(0, 1), cA + hA, voffA);
    if (wr == 1) PG8_BAR;
    PG8_WAIT_V(2); PG8_BAR;
    PG8_STAGE(PG8_SB(1, 0), cB + kstep, voffB); PG8_STAGE(PG8_SA(1, 0), cA + kstep, voffA); PG8_STAGE(PG8_SB(1, 1), cB + hB + kstep, voffB);
    PG8_WAIT_V(6); PG8_BAR;
    for (;;) {
        const bool has_next = S.next(ui + 1, nxt);
        const char* nA = has_next ? PG8_UA(nxt) : cA; const char* nB = has_next ? PG8_UB(nxt) : cB;
        for (int t = 0; t < nt; t += 2) {
            const bool last = (t == nt - 2);
            const char* a1 = cA + (size_t)(t + 1) * kstep;
            const char* a2 = last ? nA : cA + (size_t)(t + 2) * kstep; const char* b2 = last ? nB : cB + (size_t)(t + 2) * kstep;
            const char* a3 = a2 + kstep; const char* b3 = b2 + kstep;
            PG8_LDB(B0, 0, 0); PG8_LDB(B1, 0, 1); PG8_SCHED; PG8_LDA(At, 0, 0); PG8_STAGE(PG8_SA(1, 1), a1 + hA, voffA);
            PG8_WAIT_V(8); PG8_WAIT_L(0); PG8_BAR; PG8_MMA(0, 0, At, B0); PG8_MMA(0, 1, At, B1); PG8_BAR; PG8_SCHED;
            PG8_LDA(At, 0, 1); PG8_STAGE(PG8_SB(0, 0), b2, voffB); PG8_STAGE(PG8_SB(0, 1), b2 + hB, voffB); PG8_STAGE(PG8_SA(0, 0), a2, voffA);
            PG8_WAIT_V(8); PG8_WAIT_L(0); PG8_BAR; PG8_MMA(1, 0, At, B0); PG8_MMA(1, 1, At, B1); PG8_BAR; PG8_SCHED;
            PG8_LDB(B0, 1, 0); PG8_LDB(B1, 1, 1); PG8_SCHED; PG8_LDA(At, 1, 0); PG8_STAGE(PG8_SA(0, 1), a2 + hA, voffA);
            PG8_WAIT_V(8); PG8_WAIT_L(0); PG8_BAR; PG8_MMA(0, 0, At, B0); PG8_MMA(0, 1, At, B1); PG8_BAR; PG8_SCHED;
            PG8_LDA(At, 1, 1); PG8_STAGE(PG8_SB(1, 0), b3, voffB); PG8_STAGE(PG8_SB(1, 1), b3 + hB, voffB); PG8_STAGE(PG8_SA(1, 0), a3, voffA);
            PG8_WAIT_V(8); PG8_WAIT_L(0); PG8_BAR; PG8_MMA(1, 0, At, B0); PG8_MMA(1, 1, At, B1); PG8_BAR; PG8_SCHED;
        }
        if (wr == 0) PG8_BAR;
        E(acc, cur, wr, wc, fr, fq);
        if (!has_next) break;
        if (!E.keep(cur)) {
#pragma unroll
            for (int a = 0; a < 2; ++a)
#pragma unroll
                for (int b = 0; b < 2; ++b)
#pragma unroll
                    for (int m = 0; m < 4; ++m)
#pragma unroll
                        for (int n = 0; n < 2; ++n) acc[a][b][m][n] = (f32x4){0.f, 0.f, 0.f, 0.f};
        }
        cur = nxt; cA = nA; cB = nB; ++ui;
        if (wr == 1) PG8_BAR;
    }
    PG8_WAIT_V(0);
    PG8_BAR;
#undef PG8_SA
#undef PG8_SB
#undef PG8_STAGE
#undef PG8_LDA
#undef PG8_LDB
#undef PG8_MMA
#undef PG8_WAIT_V
#undef PG8_WAIT_L
#undef PG8_BAR
#undef PG8_SCHED
#undef PG8_UA
#undef PG8_UB
}
}

__device__ __forceinline__ void transpose_item(const float* W, int N, bf16_t* WT, int ldt, int row_off, int koff, LAS float* scr, int item, int lane) {
    const int nblk = N / 32, kb = item / nblk, nb = item % nblk, k0 = 64 * kb, n0 = 32 * nb;
#pragma unroll 8
    for (int i = 0; i < 32; ++i) { const int kk = 2 * i + (lane >> 5); scr[kk * 33 + (lane & 31)] = W[(size_t)(k0 + kk) * N + n0 + (lane & 31)]; }
    LDS_WAIT(); asm volatile("" ::: "memory");
    const int c = lane & 7;
#pragma unroll
    for (int j = 0; j < 4; ++j) { const int n = (lane >> 3) + 8 * j; const LAS float* s = scr + (8 * c) * 33 + n;
        u32x4 o; o.x = cvt_pk_bf16(s[0 * 33], s[1 * 33]); o.y = cvt_pk_bf16(s[2 * 33], s[3 * 33]); o.z = cvt_pk_bf16(s[4 * 33], s[5 * 33]); o.w = cvt_pk_bf16(s[6 * 33], s[7 * 33]);
        *(u32x4*)(WT + (size_t)(row_off + n0 + n) * ldt + koff + k0 + 8 * c) = o; }
    LDS_WAIT(); asm volatile("" ::: "memory");
}
__device__ __forceinline__ void transpose_matrix(const float* W, int K, int N, bf16_t* WT, int ldt, int row_off, int koff, LAS float* scr, int gw, int NGW, int lane) {
    const int nitems = (K / 64) * (N / 32);
    for (int it = gw; it < nitems; it += NGW) transpose_item(W, N, WT, ldt, row_off, koff, scr, it, lane);
}
__device__ __forceinline__ void convert_rows(const float* src, bf16_t* dst, size_t n, int gtid, int gthreads) {
    for (size_t i = (size_t)gtid * 8; i < n; i += (size_t)gthreads * 8) {
        const f32x4 a = *(const f32x4*)(src + i), b = *(const f32x4*)(src + i + 4);
        u32x4 o; o.x = cvt_pk_bf16(a[0], a[1]); o.y = cvt_pk_bf16(a[2], a[3]); o.z = cvt_pk_bf16(b[0], b[1]); o.w = cvt_pk_bf16(b[2], b[3]);
        *(u32x4*)(dst + i) = o;
    }
}

__device__ __forceinline__ void ln_rows(float* io, bf16_t* xn, const float* gam, const float* bet, int nrows, int gw, int NGW, int lane) {
    f32x4 gv[4], bv[4];
#pragma unroll
    for (int j = 0; j < 4; ++j) { gv[j] = *(const f32x4*)(gam + 4 * lane + 256 * j); bv[j] = *(const f32x4*)(bet + 4 * lane + 256 * j); }
    for (int r = gw; r < nrows; r += NGW) {
        f32x4* xr = (f32x4*)(io + (size_t)r * D) + lane;
        f32x4 v[4]; float s = 0.f;
#pragma unroll
        for (int j = 0; j < 4; ++j) { v[j] = xr[64 * j]; s += (v[j][0] + v[j][1]) + (v[j][2] + v[j][3]); }
        const float mean = wave_sum(s) * (1.f / D); float s2 = 0.f;
#pragma unroll
        for (int j = 0; j < 4; ++j) { v[j] = v[j] - mean; s2 += (v[j][0] * v[j][0] + v[j][1] * v[j][1]) + (v[j][2] * v[j][2] + v[j][3] * v[j][3]); }
        const float rstd = 1.f / sqrtf(wave_sum(s2) * (1.f / D) + LN_EPS);
        u32x2* o8 = (u32x2*)(xn + (size_t)r * D) + lane;
#pragma unroll
        for (int j = 0; j < 4; ++j) { const f32x4 y = v[j] * rstd * gv[j] + bv[j]; xr[64 * j] = y; u32x2 w; w.x = cvt_pk_bf16(y[0], y[1]); w.y = cvt_pk_bf16(y[2], y[3]); o8[64 * j] = w; }
    }
}

__device__ __forceinline__ void conv_phase(const bf16_t* P, bf16_t* Y, const float* cw  , int gtid, int gthreads) {
    constexpr int RUN = 16;
    const int nwork = (RC / RUN) * 64;
    for (int wi = gtid; wi < nwork; wi += gthreads) {
        const int cg8 = wi & 63, run = wi >> 6, c0 = cg8 * 8, r0 = run * RUN;
        float w0[8], w1[8], w2[8];
#pragma unroll
        for (int j = 0; j < 8; ++j) { w0[j] = cw[c0 + j]; w1[j] = cw[512 + c0 + j]; w2[j] = cw[1024 + c0 + j]; }
        float um2[8], um1[8];
        const bool head = (r0 % SEQ) == 0;
#pragma unroll
        for (int j = 0; j < 8; ++j) { um2[j] = 0.f; um1[j] = 0.f; }
        if (!head) {
            const u32x4 c2 = *(const u32x4*)(P + (size_t)(r0 - 2) * INC + C_CC + c0), h2 = *(const u32x4*)(P + (size_t)(r0 - 2) * INC + C_CH + c0);
            const u32x4 c1 = *(const u32x4*)(P + (size_t)(r0 - 1) * INC + C_CC + c0), h1 = *(const u32x4*)(P + (size_t)(r0 - 1) * INC + C_CH + c0);
#pragma unroll
            for (int q = 0; q < 4; ++q) { um2[2 * q] = bflo(c2[q]) * bflo(h2[q]); um2[2 * q + 1] = bfhi(c2[q]) * bfhi(h2[q]); um1[2 * q] = bflo(c1[q]) * bflo(h1[q]); um1[2 * q + 1] = bfhi(c1[q]) * bfhi(h1[q]); }
        }
        for (int t = 0; t < RUN; ++t) {
            const size_t r = (size_t)(r0 + t);
            const u32x4 cc = *(const u32x4*)(P + r * INC + C_CC + c0), ch = *(const u32x4*)(P + r * INC + C_CH + c0), cb = *(const u32x4*)(P + r * INC + C_CB + c0);
            float u[8], y[8];
#pragma unroll
            for (int q = 0; q < 4; ++q) { u[2 * q] = bflo(cc[q]) * bflo(ch[q]); u[2 * q + 1] = bfhi(cc[q]) * bfhi(ch[q]); }
#pragma unroll
            for (int q = 0; q < 4; ++q) { y[2 * q] = bflo(cb[q]) * (w0[2 * q] * um2[2 * q] + w1[2 * q] * um1[2 * q] + w2[2 * q] * u[2 * q]);
                                          y[2 * q + 1] = bfhi(cb[q]) * (w0[2 * q + 1] * um2[2 * q + 1] + w1[2 * q + 1] * um1[2 * q + 1] + w2[2 * q + 1] * u[2 * q + 1]); }
            u32x4 o; o.x = cvt_pk_bf16(y[0], y[1]); o.y = cvt_pk_bf16(y[2], y[3]); o.z = cvt_pk_bf16(y[4], y[5]); o.w = cvt_pk_bf16(y[6], y[7]);
            *(u32x4*)(Y + r * YW + c0) = o;
#pragma unroll
            for (int j = 0; j < 8; ++j) { um2[j] = um1[j]; um1[j] = u[j]; }
        }
    }
}

constexpr int AT_KP = 136, AT_VP = 264, AT_VOFF = 256 * AT_KP * 2;
static_assert(AT_VOFF + 128 * AT_VP * 2 <= LDS_BYTES, "attention LDS");
__device__ __forceinline__ void attn_unit(LAS unsigned char* lds, const bf16_t* P, const bf16_t* MKV  , bf16_t* Y, int chunk, int unit) {
    const int tid = opaque_tid(), w = tid >> 6, lane = tid & 63, c = lane & 15, g = lane >> 4;
    const int qt = unit & 15, h = (unit >> 4) & 3, bl = unit >> 6, b = chunk * BPC + bl;
    LAS bf16_t* KS = (LAS bf16_t*)lds; LAS bf16_t* VT = (LAS bf16_t*)(lds + AT_VOFF);
    __syncthreads();
#pragma unroll
    for (int i = 0; i < 8; ++i) {
        const int key = tid & 255, chn = (tid >> 8) + 2 * i;
        const bf16_t* src = MKV + (size_t)(b * MEML + key) * 4096 + h * 128 + chn * 8;
        const u32x4 kv = *(const u32x4*)src; const u32x4 vv = *(const u32x4*)(src + 512);
        *(LAS u32x4*)(KS + key * AT_KP + chn * 8) = kv;
#pragma unroll
        for (int q = 0; q < 4; ++q) { VT[(chn * 8 + 2 * q) * AT_VP + key] = (bf16_t)(vv[q] & 0xffffu); VT[(chn * 8 + 2 * q + 1) * AT_VP + key] = (bf16_t)(vv[q] >> 16); }
    }
    __syncthreads();
    const float scale = 0.08838834764831845f;
#pragma unroll 1
    for (int pass = 0; pass < 2; ++pass) {
        const size_t qrow0 = (size_t)bl * SEQ + qt * 256 + w * 32 + pass * 16;
        bf16x8 qb[4];
#pragma unroll
        for (int ks = 0; ks < 4; ++ks) qb[ks] = *(const bf16x8*)(P + (qrow0 + c) * INC + C_MQ + h * 128 + ks * 32 + g * 8);
        f32x4 sc[16];
#pragma unroll
        for (int kt = 0; kt < 16; ++kt) {
            sc[kt] = (f32x4){0.f, 0.f, 0.f, 0.f};
#pragma unroll
            for (int ks = 0; ks < 4; ++ks) { const bf16x8 ka = *(const LAS bf16x8*)(KS + (kt * 16 + c) * AT_KP + ks * 32 + g * 8); sc[kt] = __builtin_amdgcn_mfma_f32_16x16x32_bf16(ka, qb[ks], sc[kt], 0, 0, 0); }
            if (kt & 1) asm volatile("" ::: "memory");
        }
        float mx = -3.0e38f;
#pragma unroll
        for (int kt = 0; kt < 16; ++kt) mx = fmaxf(mx, fmaxf(fmaxf(sc[kt][0], sc[kt][1]), fmaxf(sc[kt][2], sc[kt][3])));
        mx = fmaxf(mx, __shfl_xor(mx, 16)); mx = fmaxf(mx, __shfl_xor(mx, 32));
        float sum = 0.f;
#pragma unroll
        for (int kt = 0; kt < 16; ++kt)
#pragma unroll
            for (int r = 0; r < 4; ++r) { const float p = __expf((sc[kt][r] - mx) * scale); sc[kt][r] = p; sum += p; }
        sum += __shfl_xor(sum, 16); sum += __shfl_xor(sum, 32);
        const float rs = 1.0f / sum;
        bf16x8 pa[8];
#pragma unroll
        for (int k2 = 0; k2 < 8; ++k2) {
            u32x4 wv; wv.x = cvt_pk_bf16_c(sc[2 * k2][0] * rs, sc[2 * k2][1] * rs); wv.y = cvt_pk_bf16_c(sc[2 * k2][2] * rs, sc[2 * k2][3] * rs);
            wv.z = cvt_pk_bf16_c(sc[2 * k2 + 1][0] * rs, sc[2 * k2 + 1][1] * rs); wv.w = cvt_pk_bf16_c(sc[2 * k2 + 1][2] * rs, sc[2 * k2 + 1][3] * rs);
            pa[k2] = __builtin_bit_cast(bf16x8, wv);
        }
#pragma unroll
        for (int dt = 0; dt < 8; ++dt) {
            f32x4 o = (f32x4){0.f, 0.f, 0.f, 0.f};
#pragma unroll
            for (int k2 = 0; k2 < 8; ++k2) {
                const s16x4 lo = *(const LAS s16x4*)(VT + (dt * 16 + c) * AT_VP + k2 * 32 + 4 * g), hi = *(const LAS s16x4*)(VT + (dt * 16 + c) * AT_VP + k2 * 32 + 16 + 4 * g);
                const bf16x8 vb = (bf16x8){lo[0], lo[1], lo[2], lo[3], hi[0], hi[1], hi[2], hi[3]};
                o = __builtin_amdgcn_mfma_f32_16x16x32_bf16(pa[k2], vb, o, 0, 0, 0);
            }
#pragma unroll
            for (int r = 0; r < 4; ++r) Y[(qrow0 + 4 * g + r) * YW + 1024 + h * 128 + dt * 16 + c] = f2bf(o[r]);
            asm volatile("" ::: "memory");
        }
    }
}

constexpr int HG_QA = 0, HG_KB = 8704, HG_KBT = 17408, HG_VT = 27648, HG_TOT = 37888, HG_SREF = 39936, HG_SLAST = 40448, HG_SSQ = 40960, HG_P = 136, HG_TP = 40;
template <bool OUT>
__device__ __forceinline__ void hgrn_item(LAS unsigned char* lds, const bf16_t* P, bf16_t* Y, float* Sloc, float* Dloc, const float* lbraw, const float* normw, int layer, int item) {
    const int tid = opaque_tid(), w = tid >> 6, lane = tid & 63, c = lane & 15, g = lane >> 4;
    const int seg = item & (NSEG - 1), h = (item >> 4) & 3, bl = item >> 6;
    const int f = tid & 127, tg = tid >> 7;
    LAS bf16_t* QA = (LAS bf16_t*)(lds + HG_QA); LAS bf16_t* KB = (LAS bf16_t*)(lds + HG_KB); LAS bf16_t* KBT = (LAS bf16_t*)(lds + HG_KBT); LAS bf16_t* VT = (LAS bf16_t*)(lds + HG_VT);
    LAS float* TOT = (LAS float*)(lds + HG_TOT); LAS float* SREF = (LAS float*)(lds + HG_SREF); LAS float* SLAST = (LAS float*)(lds + HG_SLAST); LAS float* SSQ = (LAS float*)(lds + HG_SSQ);
    float lb;
    { const int chn = h * 128 + f; const float l0 = lbraw[chn], l1 = lbraw[512 + chn], l2 = lbraw[1024 + chn], l3 = lbraw[1536 + chn];
      const float mx = fmaxf(fmaxf(l0, l1), fmaxf(l2, l3)); const float e0 = __expf(l0 - mx), e1 = __expf(l1 - mx), e2 = __expf(l2 - mx), e3 = __expf(l3 - mx);
      const float inv = 1.0f / (e0 + e1 + e2 + e3);
      lb = (layer == 0) ? 0.f : ((layer == 1) ? e1 : ((layer == 2) ? (e1 + e2) : (e1 + e2 + e3))) * inv; }
    const float oml = 1.0f - lb;
    f32x4 S[8];
#pragma unroll
    for (int ft = 0; ft < 8; ++ft) S[ft] = (f32x4){0.f, 0.f, 0.f, 0.f};
    const int ibase = (bl * 4 + h) * NSEG;
    if (OUT) {
        for (int m = 0; m < seg; ++m) {
            const float* sl = Sloc + (size_t)(ibase + m) * 16384; const float* dl = Dloc + (size_t)(ibase + m) * 128;
#pragma unroll
            for (int ft = 0; ft < 8; ++ft) { const f32x4 dd = *(const f32x4*)(dl + 16 * ft + 4 * g);
#pragma unroll
                for (int j = 0; j < 4; ++j) S[ft][j] = S[ft][j] * dd[j] + sl[(size_t)(16 * ft + 4 * g + j) * 128 + 16 * w + c]; }
        }
    }
    const size_t row0 = (size_t)bl * SEQ + (size_t)seg * HSEG;
    float btot = 0.f;
    __syncthreads();
#pragma unroll 1
    for (int ck = 0; ck < HSEG / 32; ++ck) {
        const size_t rb = row0 + ck * 32 + tg * 8;
        float cs[8], qs[8], kk[8]; unsigned short vraw[8];
#pragma unroll
        for (int e = 0; e < 8; ++e) {
            const bf16_t* pr = P + (rb + e) * INC + h * 128 + f;
            float fl = bf2f(pr[C_HF]); const float qv = bf2f(pr[C_HQ]); vraw[e] = pr[C_HI];
            fl = fminf(fmaxf(fl, -30.f), 30.f);
            const float ex = __expf(-fl), sg = 1.0f / (1.0f + ex);
            cs[e] = __logf(lb + oml * sg); kk[e] = oml * ex * sg; qs[e] = qv * sigmoidf_(qv);
        }
#pragma unroll
        for (int e = 1; e < 8; ++e) cs[e] += cs[e - 1];
        TOT[tg * 128 + f] = cs[7];
        __syncthreads();
        const float t0 = TOT[f], t1 = TOT[128 + f], t2 = TOT[256 + f], t3 = TOT[384 + f];
        const float off = (tg > 0 ? t0 : 0.f) + (tg > 1 ? t1 : 0.f) + (tg > 2 ? t2 : 0.f);
        const float bref = t0 + t1, blast = (t0 + t1) + (t2 + t3);
        btot += blast;
        unsigned short kbr[8];
#pragma unroll
        for (int e = 0; e < 8; ++e) {
            const float bc = off + cs[e];
            const float qa = qs[e] * __expf(bc - bref), kb = kk[e] * __expf(bref - bc);
            QA[(tg * 8 + e) * HG_P + f] = f2bf(qa); kbr[e] = f2bf(kb); KB[(tg * 8 + e) * HG_P + f] = kbr[e];
        }
        { u32x4 wv; wv.x = kbr[0] | ((unsigned)kbr[1] << 16); wv.y = kbr[2] | ((unsigned)kbr[3] << 16); wv.z = kbr[4] | ((unsigned)kbr[5] << 16); wv.w = kbr[6] | ((unsigned)kbr[7] << 16);
          *(LAS u32x4*)(KBT + f * HG_TP + tg * 8) = wv;
          u32x4 vv; vv.x = vraw[0] | ((unsigned)vraw[1] << 16); vv.y = vraw[2] | ((unsigned)vraw[3] << 16); vv.z = vraw[4] | ((unsigned)vraw[5] << 16); vv.w = vraw[6] | ((unsigned)vraw[7] << 16);
          *(LAS u32x4*)(VT + f * HG_TP + tg * 8) = vv; }
        if (tg == 0) { SREF[f] = __expf(bref); SLAST[f] = __expf(blast - bref); }
        __syncthreads();
#pragma unroll
        for (int ft = 0; ft < 8; ++ft) { const f32x4 sr = *(const LAS f32x4*)(SREF + 16 * ft + 4 * g); S[ft] = S[ft] * sr; }
        f32x4 O0 = (f32x4){0.f, 0.f, 0.f, 0.f}, O1 = O0;
        if (OUT) {
            f32x4 sc00 = (f32x4){0.f, 0.f, 0.f, 0.f}, sc01 = sc00, sc11 = sc00;
#pragma unroll
            for (int ks = 0; ks < 4; ++ks) {
                const bf16x8 kb0 = *(const LAS bf16x8*)(KB + c * HG_P + ks * 32 + g * 8), kb1 = *(const LAS bf16x8*)(KB + (16 + c) * HG_P + ks * 32 + g * 8);
                const bf16x8 qa0 = *(const LAS bf16x8*)(QA + c * HG_P + ks * 32 + g * 8), qa1 = *(const LAS bf16x8*)(QA + (16 + c) * HG_P + ks * 32 + g * 8);
                sc00 = __builtin_amdgcn_mfma_f32_16x16x32_bf16(kb0, qa0, sc00, 0, 0, 0);
                sc01 = __builtin_amdgcn_mfma_f32_16x16x32_bf16(kb0, qa1, sc01, 0, 0, 0);
                sc11 = __builtin_amdgcn_mfma_f32_16x16x32_bf16(kb1, qa1, sc11, 0, 0, 0);
            }
#pragma unroll
            for (int r = 0; r < 4; ++r) { if (4 * g + r > c) { sc00[r] = 0.f; sc11[r] = 0.f; } }
            u32x4 p0w, p1w;
            p0w.x = cvt_pk_bf16_c(sc00[0], sc00[1]); p0w.y = cvt_pk_bf16_c(sc00[2], sc00[3]); p0w.z = 0u; p0w.w = 0u;
            p1w.x = cvt_pk_bf16_c(sc01[0], sc01[1]); p1w.y = cvt_pk_bf16_c(sc01[2], sc01[3]); p1w.z = cvt_pk_bf16_c(sc11[0], sc11[1]); p1w.w = cvt_pk_bf16_c(sc11[2], sc11[3]);
            const s16x4 vlo = *(const LAS s16x4*)(VT + (16 * w + c) * HG_TP + 4 * g), vhi = *(const LAS s16x4*)(VT + (16 * w + c) * HG_TP + 16 + 4 * g);
            const bf16x8 vb = (bf16x8){vlo[0], vlo[1], vlo[2], vlo[3], vhi[0], vhi[1], vhi[2], vhi[3]};
            O0 = __builtin_amdgcn_mfma_f32_16x16x32_bf16(__builtin_bit_cast(bf16x8, p0w), vb, O0, 0, 0, 0);
            O1 = __builtin_amdgcn_mfma_f32_16x16x32_bf16(__builtin_bit_cast(bf16x8, p1w), vb, O1, 0, 0, 0);
#pragma unroll
            for (int ks = 0; ks < 4; ++ks) {
                const s16x4 q0l = *(const LAS s16x4*)(QA + c * HG_P + ks * 32 + 4 * g), q0h = *(const LAS s16x4*)(QA + c * HG_P + ks * 32 + 16 + 4 * g);
                const s16x4 q1l = *(const LAS s16x4*)(QA + (16 + c) * HG_P + ks * 32 + 4 * g), q1h = *(const LAS s16x4*)(QA + (16 + c) * HG_P + ks * 32 + 16 + 4 * g);
                const bf16x8 qa0 = (bf16x8){q0l[0], q0l[1], q0l[2], q0l[3], q0h[0], q0h[1], q0h[2], q0h[3]};
                const bf16x8 qa1 = (bf16x8){q1l[0], q1l[1], q1l[2], q1l[3], q1h[0], q1h[1], q1h[2], q1h[3]};
                u32x4 sw; sw.x = cvt_pk_bf16_c(S[2 * ks][0], S[2 * ks][1]); sw.y = cvt_pk_bf16_c(S[2 * ks][2], S[2 * ks][3]); sw.z = cvt_pk_bf16_c(S[2 * ks + 1][0], S[2 * ks + 1][1]); sw.w = cvt_pk_bf16_c(S[2 * ks + 1][2], S[2 * ks + 1][3]);
                const bf16x8 sb = __builtin_bit_cast(bf16x8, sw);
                O0 = __builtin_amdgcn_mfma_f32_16x16x32_bf16(qa0, sb, O0, 0, 0, 0);
                O1 = __builtin_amdgcn_mfma_f32_16x16x32_bf16(qa1, sb, O1, 0, 0, 0);
            }
        }
        { const bf16x8 vb2 = *(const LAS bf16x8*)(VT + (16 * w + c) * HG_TP + 8 * g);
#pragma unroll
          for (int ft = 0; ft < 8; ++ft) {
              const bf16x8 ka = *(const LAS bf16x8*)(KBT + (16 * ft + c) * HG_TP + 8 * g);
              S[ft] = __builtin_amdgcn_mfma_f32_16x16x32_bf16(ka, vb2, S[ft], 0, 0, 0);
              const f32x4 sl = *(const LAS f32x4*)(SLAST + 16 * ft + 4 * g); S[ft] = S[ft] * sl;
          } }
        if (OUT) {
            float q0[4], q1[4];
#pragma unroll
            for (int r = 0; r < 4; ++r) { q0[r] = O0[r] * O0[r]; q1[r] = O1[r] * O1[r]; }
#pragma unroll
            for (int o = 1; o < 16; o <<= 1)
#pragma unroll
                for (int r = 0; r < 4; ++r) { q0[r] += __shfl_xor(q0[r], o); q1[r] += __shfl_xor(q1[r], o); }
            if (c == 0) {
#pragma unroll
                for (int r = 0; r < 4; ++r) { SSQ[w * 32 + 4 * g + r] = q0[r]; SSQ[w * 32 + 16 + 4 * g + r] = q1[r]; } }
            __syncthreads();
            const int v = 16 * w + c; const float nw = normw[v];
#pragma unroll
            for (int tt = 0; tt < 2; ++tt)
#pragma unroll
                for (int r = 0; r < 4; ++r) {
                    const int t = 16 * tt + 4 * g + r; float tot = 0.f;
#pragma unroll
                    for (int ww = 0; ww < 8; ++ww) tot += SSQ[ww * 32 + t];
                    const float rinv = 1.0f / sqrtf(tot * (1.0f / 128.0f) + RMS_EPS);
                    const size_t row = row0 + ck * 32 + t;
                    const float gv = bf2f(P[row * INC + C_HG + h * 128 + v]);
                    const float ov = (tt == 0 ? O0[r] : O1[r]) * rinv * nw * (gv * sigmoidf_(gv));
                    Y[row * YW + 512 + h * 128 + v] = f2bf(ov);
                }
        }
    }
    if (!OUT) {
        float* sl = Sloc + (size_t)(ibase + seg) * 16384;
#pragma unroll
        for (int ft = 0; ft < 8; ++ft)
#pragma unroll
            for (int j = 0; j < 4; ++j) sl[(size_t)(16 * ft + 4 * g + j) * 128 + 16 * w + c] = S[ft][j];
        if (tg == 0) Dloc[(size_t)(ibase + seg) * 128 + f] = __expf(btot);
    }
    __syncthreads();
}


#define XB_TMO      128
#define XB_XCNT(j)  (256  + 64 * (j))
#define XB_XSUB(j)  (1280 + 64 * (j))
#define XB_XGEN(j)  (2304 + 64 * (j))
#define XB_TOP      3328
#define XB_TOPGEN   3392
#define XCD_BAR_WORDS 3456
#define XB_SPIN_CAP (1u << 20)
__device__ __forceinline__ unsigned xb_ld(unsigned* p)              { return __hip_atomic_load(p, __ATOMIC_RELAXED, __HIP_MEMORY_SCOPE_AGENT); }
__device__ __forceinline__ unsigned xb_add(unsigned* p, unsigned v) { return __hip_atomic_fetch_add(p, v, __ATOMIC_RELAXED, __HIP_MEMORY_SCOPE_AGENT); }
__device__ __forceinline__ unsigned xb_xcc_id() { return (unsigned)__builtin_amdgcn_s_getreg((3 << 11) | 20) & 0xFu; }
#define XB_SPIN(cond, bar) do { unsigned _sp = 0; while (cond) { __builtin_amdgcn_s_sleep(1); \
    if ((++_sp & 255u) == 0u) { if (xb_ld(&(bar)[XB_TMO])) break; if (_sp > XB_SPIN_CAP) { atomicAdd(&(bar)[XB_TMO], 1u); break; } } } } while (0)
struct XcdBarrier { unsigned* bar; unsigned x; volatile LAS unsigned* st; };
__device__ __forceinline__ XcdBarrier xcd_barrier_post(unsigned* bar, volatile LAS unsigned* st) {
    XcdBarrier b; b.bar = bar; b.x = xb_xcc_id(); b.st = st;
    if (threadIdx.x == 0) (void)xb_add(&bar[XB_XCNT(b.x)], 1u);
    return b;
}
__device__ __forceinline__ void xcd_barrier_complete(unsigned* bar, unsigned x, unsigned& nloc, unsigned& nx) {
    const unsigned G = gridDim.x * gridDim.y * gridDim.z;
    unsigned sum, cnt, mine, sp = 0u;
    for (;;) {
        sum = 0u; cnt = 0u; mine = 0u;
#pragma unroll
        for (unsigned j = 0; j < 16; ++j) { const unsigned c = xb_ld(&bar[XB_XCNT(j)]); sum += c; cnt += (c > 0u) ? 1u : 0u; mine = (j == x) ? c : mine; }
        if (sum == G) break;
        __builtin_amdgcn_s_sleep(1);
        if ((++sp & 255u) == 0u) { if (xb_ld(&bar[XB_TMO])) break; if (sp > XB_SPIN_CAP) { atomicAdd(&bar[XB_TMO], 1u); break; } }
    }
    nloc = mine > 0u ? mine : 1u; nx = cnt > 0u ? cnt : 1u;
}
__device__ __forceinline__ void xcd_barrier(const XcdBarrier& b) {
    asm volatile("s_waitcnt vmcnt(0)" ::: "memory");
    __syncthreads();
    if (threadIdx.x == 0) {
        unsigned* bar = b.bar;
        __builtin_amdgcn_s_waitcnt(0);
        unsigned nloc = b.st[0], nx = b.st[1];
        if (nloc == 0u) { xcd_barrier_complete(bar, b.x, nloc, nx); b.st[0] = nloc; b.st[1] = nx; }
        const unsigned old = xb_add(&bar[XB_XSUB(b.x)], 1u);
        const unsigned gen = old / nloc;
        if (old + 1u == (gen + 1u) * nloc) {
            __builtin_amdgcn_fence(__ATOMIC_RELEASE, "agent");
            asm volatile("s_waitcnt vmcnt(0)" ::: "memory");
            const unsigned og = xb_add(&bar[XB_TOP], 1u);
            const unsigned tg = og / nx;
            if (og + 1u == (tg + 1u) * nx) xb_add(&bar[XB_TOPGEN], 1u);
            else XB_SPIN(xb_ld(&bar[XB_TOPGEN]) == tg, bar);
            __builtin_amdgcn_fence(__ATOMIC_ACQUIRE, "agent");
            xb_add(&bar[XB_XGEN(b.x)], 1u);
            asm volatile("s_waitcnt vmcnt(0)" ::: "memory");
        } else {
            XB_SPIN(xb_ld(&bar[XB_XGEN(b.x)]) == gen, bar);
            __builtin_amdgcn_fence(__ATOMIC_ACQUIRE, "agent");
            asm volatile("s_waitcnt vmcnt(0)" ::: "memory");
        }
    }
    __syncthreads();
}

struct Args { const float* in[17]; float* out; unsigned char* ws; int coop, ph; };
__global__ void __launch_bounds__(512, 2) mega_fwd(Args args) {
    extern __shared__ __attribute__((aligned(16))) unsigned char lds_raw[];
    LAS unsigned char* lds = (LAS unsigned char*)lds_raw;
    cg::grid_group grid = cg::this_grid();
    const int G = gridDim.x, bx = blockIdx.x, NGW = G * 8, gthreads = G * 512;
#define PH_VARS const int tid = opaque_tid(), lane = tid & 63, wave = __builtin_amdgcn_readfirstlane(tid >> 6), gw = bx * 8 + wave, gtid = bx * 512 + tid; (void)lane; (void)gw; (void)gtid
    const float *x = args.in[0], *mem = args.in[1], *lbraw = args.in[2], *w_in = args.in[3], *conv_w = args.in[4], *hg_norm_w = args.in[5], *w_mem_k = args.in[6], *w_mem_v = args.in[7],
                *w_branch = args.in[8], *b_gate = args.in[9], *w_o = args.in[10], *ln1_g = args.in[11], *ln1_b = args.in[12], *w_up = args.in[13], *w_down = args.in[14], *ln2_g = args.in[15], *ln2_b = args.in[16];
    unsigned char* ws = args.ws; float* out = args.out;
    bf16_t *WinT = (bf16_t*)(ws + WS_WIN), *WkvT = (bf16_t*)(ws + WS_WKV), *WbT = (bf16_t*)(ws + WS_WB), *WoT = (bf16_t*)(ws + WS_WO), *WupT = (bf16_t*)(ws + WS_WUP), *WdnT = (bf16_t*)(ws + WS_WDN);
    bf16_t *XN = (bf16_t*)(ws + WS_XN), *MEMB = (bf16_t*)(ws + WS_MEMB), *MKV = (bf16_t*)(ws + WS_MKV), *Y = (bf16_t*)(ws + WS_Y), *MG = (bf16_t*)(ws + WS_MG), *PROJ = (bf16_t*)(ws + WS_PROJ), *HB = (bf16_t*)(ws + WS_H);
    float *Sloc = (float*)(ws + WS_SLOC), *Dloc = (float*)(ws + WS_DLOC);
    int pid = 0;
    unsigned* barw = (unsigned*)(ws + WS_CTL);
    volatile LAS unsigned* MISC = (volatile LAS unsigned*)(lds + LDS_BYTES - 64);
    if (threadIdx.x < 2) MISC[threadIdx.x] = 0u;
    if (bx == 0) { for (int i = threadIdx.x; i < XCD_BAR_WORDS; i += 512) __hip_atomic_store(barw + i, 0u, __ATOMIC_RELAXED, __HIP_MEMORY_SCOPE_AGENT); }
    __syncthreads();
    grid.sync();
    const XcdBarrier xbar = xcd_barrier_post(barw, MISC);
#define PHASE_IF if (args.coop || pid == args.ph)
#define PHASE_END do { if (args.coop) xcd_barrier(xbar); ++pid; } while (0)

    PHASE_IF {
        PH_VARS;
        LAS float* scr = (LAS float*)(lds + wave * 16384);
        for (int l = 0; l < DEPTH; ++l) {
            transpose_matrix(w_in + (size_t)l * D * INC, D, INC, WinT + (size_t)l * INC * D, D, 0, 0, scr, gw, NGW, lane);
            transpose_matrix(w_mem_k + (size_t)l * D * 512, D, 512, WkvT, D, l * 1024, 0, scr, gw, NGW, lane);
            transpose_matrix(w_mem_v + (size_t)l * D * 512, D, 512, WkvT, D, l * 1024 + 512, 0, scr, gw, NGW, lane);
            for (int j = 0; j < 3; ++j) transpose_matrix(w_branch + ((size_t)l * 3 + j) * 512 * D, 512, D, WbT + (size_t)l * D * YW, YW, 0, j * 512, scr, gw, NGW, lane);
            transpose_matrix(w_o + (size_t)l * D * D, D, D, WoT + (size_t)l * D * D, D, 0, 0, scr, gw, NGW, lane);
            transpose_matrix(w_up + (size_t)l * D * FF, D, FF, WupT + (size_t)l * FF * D, D, 0, 0, scr, gw, NGW, lane);
            transpose_matrix(w_down + (size_t)l * FF * D, FF, D, WdnT + (size_t)l * D * FF, FF, 0, 0, scr, gw, NGW, lane);
        }
        convert_rows(x, XN, (size_t)M * D, gtid, gthreads);
        convert_rows(mem, MEMB, (size_t)NBATCH * MEML * D, gtid, gthreads);
        __syncthreads();
    }
    PHASE_END;
    PHASE_IF {
        pg8::Gemm gm{MEMB, WkvT, D, D, D}; pg8::Order S; S.init(16, 16, G, bx, 1);
        pg8::EpiStore<0> E{MKV, 4096, nullptr};

#ifndef NO_G_MKV
                pg8::gemm_phase(lds, gm, S, E);
#endif

    }
    PHASE_END;
    for (int l = 0; l < DEPTH; ++l) {
        for (int ch = 0; ch < NCH; ++ch) {
            const size_t crow = (size_t)ch * RC;
            PHASE_IF {
                pg8::Gemm gm{XN + crow * D, WinT + (size_t)l * INC * D, D, D, D}; pg8::Order S; S.init(RC / 256, INC / 256, G, bx, 1);
                pg8::EpiStore<1> E{PROJ, INC, b_gate + (size_t)l * 3 * D};

#ifndef NO_G_INP
                pg8::gemm_phase(lds, gm, S, E);
#endif

            }
            PHASE_END;
            PHASE_IF {
                #ifndef NO_HG1
                for (int it = bx; it < BPC * 4 * NSEG; it += G) hgrn_item<false>(lds, PROJ, Y, Sloc, Dloc, lbraw, hg_norm_w + l * 128, l, it);
#endif
#ifndef NO_ATT
                for (int u = bx; u < BPC * 4 * 16; u += G) attn_unit(lds, PROJ, MKV + l * 1024, Y, ch, u);
#endif
#ifndef NO_CONV
                { PH_VARS; conv_phase(PROJ, Y, conv_w + (size_t)l * 3 * 512, gtid, gthreads); }
#endif
                __syncthreads();
            }
            PHASE_END;
            PHASE_IF {
#ifndef NO_HG3
                for (int it = bx; it < BPC * 4 * NSEG; it += G) hgrn_item<true>(lds, PROJ, Y, Sloc, Dloc, lbraw, hg_norm_w + l * 128, l, it);
#endif
            }
            PHASE_END;
            PHASE_IF {
                pg8::Gemm gm{Y, WbT + (size_t)l * D * YW, YW, YW, 512}; pg8::Order S; S.init(RC / 256, D / 256, G, bx, 3);
                pg8::EpiGate E{PROJ, MG};

#ifndef NO_G_BR
                pg8::gemm_phase(lds, gm, S, E);
#endif

            }
            PHASE_END;
            PHASE_IF {
                pg8::Gemm gm{MG, WoT + (size_t)l * D * D, D, D, D}; pg8::Order S; S.init(RC / 256, D / 256, G, bx, 1);
                pg8::EpiRes E{(l == 0 ? x : out) + crow * D, out + crow * D};

#ifndef NO_G_WO
                pg8::gemm_phase(lds, gm, S, E);
#endif

            }
            PHASE_END;
            PHASE_IF { PH_VARS; ln_rows(out + crow * D, XN + crow * D, ln1_g + l * D, ln1_b + l * D, RC, gw, NGW, lane); }
            PHASE_END;
            PHASE_IF {
                pg8::Gemm gm{XN + crow * D, WupT + (size_t)l * FF * D, D, D, D}; pg8::Order S; S.init(RC / 256, FF / 256, G, bx, 1);
                pg8::EpiStore<2> E{HB, FF, nullptr};

#ifndef NO_G_UP
                pg8::gemm_phase(lds, gm, S, E);
#endif

            }
            PHASE_END;
            PHASE_IF {
                pg8::Gemm gm{HB, WdnT + (size_t)l * D * FF, FF, FF, FF}; pg8::Order S; S.init(RC / 256, D / 256, G, bx, 1);
                pg8::EpiRes E{out + crow * D, out + crow * D};

#ifndef NO_G_DN
                pg8::gemm_phase(lds, gm, S, E);
#endif

            }
            PHASE_END;
            PHASE_IF { PH_VARS; ln_rows(out + crow * D, XN + crow * D, ln2_g + l * D, ln2_b + l * D, RC, gw, NGW, lane); }
            PHASE_END;
        }
    }
}

constexpr int N_PHASES = 2 + DEPTH * NCH * 10;

extern "C" void kernel_launch(void* const* d_in, const int* in_sizes, int n_in, void* d_out, int out_size, void* d_ws, size_t ws_size, hipStream_t stream) {
    static int grid = 0;
    if (grid == 0) {
        if (n_in != 17 || in_sizes[0] != M * D || out_size != M * D || ws_size < WS_END) { fprintf(stderr, "kernel_launch: unexpected shapes / workspace (n_in %d, ws %zu, need %zu)\n", n_in, ws_size, (size_t)WS_END); grid = -1; return; }
        int dev = 0, cus = 0, per_cu = 0;
        if (hipGetDevice(&dev) != hipSuccess || hipDeviceGetAttribute(&cus, hipDeviceAttributeMultiprocessorCount, dev) != hipSuccess) { grid = -1; return; }
        if (hipFuncSetAttribute((const void*)mega_fwd, hipFuncAttributeMaxDynamicSharedMemorySize, LDS_BYTES) != hipSuccess) { fprintf(stderr, "kernel_launch: hipFuncSetAttribute failed\n"); grid = -1; return; }
        if (hipOccupancyMaxActiveBlocksPerMultiprocessor(&per_cu, (const void*)mega_fwd, 512, LDS_BYTES) != hipSuccess || per_cu < 1) { fprintf(stderr, "kernel_launch: occupancy query says %d\n", per_cu); per_cu = 1; }
        (void)hipGetLastError();
        grid = cus * 1;
    }
    if (grid < 0) return;
    Args a{};
    for (int i = 0; i < 17; ++i) a.in[i] = (const float*)d_in[i];
    a.out = (float*)d_out; a.ws = (unsigned char*)d_ws; a.coop = 1; a.ph = 0;
    void* kargs[] = {&a};
    hipError_t e = hipLaunchCooperativeKernel((const void*)mega_fwd, dim3(grid), dim3(512), kargs, LDS_BYTES, stream);
    if (e != hipSuccess) fprintf(stderr, "kernel_launch: cooperative launch failed: %s (grid %d)\n", hipGetErrorString(e), grid);
}
```
